# Optimizing an MI355X kernel written in HIP

```python
import math
import jax, jax.numpy as jnp
from jax import lax
import numpy as np

D_MODEL = 1024
BATCH = 4
SEQ = 4096
DEPTH = 4

GRID_W = 64
N_MIXERS = 3
N_A = len(range(0, DEPTH, N_MIXERS))
N_B = len(range(1, DEPTH, N_MIXERS))
N_C = len(range(2, DEPTH, N_MIXERS))

NA_HEADS = 16
NA_HEAD_DIM = D_MODEL // NA_HEADS
NA_KH = 8
NA_KW = 16

MLA_HEADS = 16
MLA_NOPE = 64
MLA_ROPE = 32
MLA_V = D_MODEL // MLA_HEADS
MLA_Q_RANK = 256
MLA_KV_RANK = 256
ROPE_THETA = 10000.0
Q_BLOCK = 128

HG_EXPAND = 128
HG_HEADS = D_MODEL // HG_EXPAND
HG_F = HG_EXPAND
HG_V = D_MODEL // HG_HEADS
HG_CHUNK = 64

PEER_HEADS = 8
PEER_NKEYS = 128
PEER_EXPERTS = PEER_NKEYS * PEER_NKEYS
PEER_DK = 256
PEER_TOPK = 16
PEER_TOK_BLOCK = 128

NORM_EPS = 1e-5
DN_ALPHA = (2.0 * DEPTH) ** 0.25
DN_BETA = (8.0 * DEPTH) ** -0.25

kernel_name = 'hybrid_natten_mla_hgrn2_peer_encoder'

F32 = jnp.float32


def layer_norm(x, g, b):
    xf = x.astype(F32)
    mu = jnp.mean(xf, axis=-1, keepdims=True)
    var = jnp.mean(jnp.square(xf - mu), axis=-1, keepdims=True)
    return ((xf - mu) * lax.rsqrt(var + NORM_EPS) * g.astype(F32) + b.astype(F32)).astype(x.dtype)


def rms_norm(x, g):
    xf = x.astype(F32)
    y = xf * lax.rsqrt(jnp.mean(jnp.square(xf), axis=-1, keepdims=True) + NORM_EPS)
    return (y * g.astype(F32)).astype(x.dtype)


def neighborhood_attention(x, w_in, rel_bias, w_out):
    B, S, D = x.shape
    rows = S // GRID_W
    kh = min(NA_KH, rows)
    qkv = (x @ w_in).reshape(B, rows, GRID_W, 3, NA_HEADS, NA_HEAD_DIM)
    q = qkv[:, :, :, 0] * (NA_HEAD_DIM ** -0.5)
    k = qkv[:, :, :, 1]
    v = qkv[:, :, :, 2]
    cols = np.arange(GRID_W)
    c0 = np.clip(cols - NA_KW // 2, 0, GRID_W - NA_KW)
    col_idx = c0[:, None] + np.arange(NA_KW)[None, :]
    dc = col_idx - cols[:, None] + (NA_KW - 1)
    bias_c = rel_bias[:, :, dc]

    def row_step(r):
        r0 = jnp.clip(r - kh // 2, 0, rows - kh)
        k_rows = lax.dynamic_slice_in_dim(k, r0, kh, axis=1)
        v_rows = lax.dynamic_slice_in_dim(v, r0, kh, axis=1)
        k_win = k_rows[:, :, col_idx]
        v_win = v_rows[:, :, col_idx]
        q_row = lax.dynamic_index_in_dim(q, r, axis=1, keepdims=False)
        dr = r0 + jnp.arange(kh) - r + (NA_KH - 1)
        bias = jnp.take(bias_c, dr, axis=1).transpose(0, 2, 1, 3)
        s = jnp.einsum('bqhd,bkqjhd->bhqkj', q_row, k_win).astype(F32) + bias[None].astype(F32)
        p = jax.nn.softmax(s.reshape(B, NA_HEADS, GRID_W, kh * NA_KW), axis=-1)
        p = p.reshape(s.shape).astype(v.dtype)
        return jnp.einsum('bhqkj,bkqjhd->bqhd', p, v_win)

    o = lax.map(row_step, jnp.arange(rows))
    o = o.transpose(1, 0, 2, 3, 4).reshape(B, S, D)
    return o @ w_out


def apply_rope(x, cos, sin):
    half = x.shape[-1] // 2
    c = cos[None, :, None, :]
    s = sin[None, :, None, :]
    x1, x2 = x[..., :half], x[..., half:]
    return jnp.concatenate([x1 * c - x2 * s, x1 * s + x2 * c], axis=-1)


def mla_attention(x, w_in, q_norm, kv_norm, w_q_up, w_kv_up, w_out):
    B, S, D = x.shape
    dq = MLA_NOPE + MLA_ROPE
    h = x @ w_in
    cq = h[..., :MLA_Q_RANK]
    ckv = h[..., MLA_Q_RANK:MLA_Q_RANK + MLA_KV_RANK]
    k_pe = h[..., MLA_Q_RANK + MLA_KV_RANK:][:, :, None, :]
    q = (rms_norm(cq, q_norm) @ w_q_up).reshape(B, S, MLA_HEADS, dq)
    kv = (rms_norm(ckv, kv_norm) @ w_kv_up).reshape(B, S, MLA_HEADS, MLA_NOPE + MLA_V)
    half = MLA_ROPE // 2
    inv_freq = ROPE_THETA ** (-jnp.arange(half, dtype=F32) * 2.0 / MLA_ROPE)
    ang = jnp.arange(S, dtype=F32)[:, None] * inv_freq[None, :]
    cos = jnp.cos(ang).astype(x.dtype)
    sin = jnp.sin(ang).astype(x.dtype)
    q_pe = apply_rope(q[..., MLA_NOPE:], cos, sin)
    k_pe = apply_rope(k_pe, cos, sin)
    q = jnp.concatenate([q[..., :MLA_NOPE], q_pe], axis=-1) * (dq ** -0.5)
    k = jnp.concatenate([kv[..., :MLA_NOPE], jnp.broadcast_to(k_pe, (B, S, MLA_HEADS, MLA_ROPE))], axis=-1)
    v = kv[..., MLA_NOPE:]
    nb = S // Q_BLOCK
    qb = q.reshape(B, nb, Q_BLOCK, MLA_HEADS, dq).transpose(1, 0, 2, 3, 4)

    def block(qi):
        s = jnp.einsum('bqhd,bkhd->bhqk', qi, k).astype(F32)
        p = jax.nn.softmax(s, axis=-1).astype(v.dtype)
        return jnp.einsum('bhqk,bkhv->bqhv', p, v)

    o = lax.map(block, qb)
    o = o.transpose(1, 0, 2, 3, 4).reshape(B, S, MLA_HEADS * MLA_V)
    return o @ w_out


def hgrn2_chunk_scan(q, k, v, log_f):
    B, S, H, F = q.shape
    V = v.shape[-1]
    n = S // HG_CHUNK

    def to_chunks(a):
        return a.reshape(B, n, HG_CHUNK, H, a.shape[-1]).transpose(1, 0, 3, 2, 4)

    lower = jnp.tril(jnp.ones((HG_CHUNK, HG_CHUNK), dtype=bool))[None, None, :, :, None]

    def step(state, inp):
        qc, kc, vc, lc = inp
        b = jnp.cumsum(lc, axis=2)
        diff = b[:, :, :, None, :] - b[:, :, None, :, :]
        decay = jnp.exp(jnp.where(lower, diff, -jnp.inf))
        attn = jnp.einsum('bhtf,bhsf,bhtsf->bhts', qc, kc, decay)
        o = jnp.einsum('bhts,bhsv->bhtv', attn, vc) + jnp.einsum('bhtf,bhfv->bhtv', qc * jnp.exp(b), state)
        b_last = b[:, :, -1:, :]
        state = jnp.exp(b_last[:, :, 0, :])[..., None] * state + jnp.einsum('bhsf,bhsv->bhfv', kc * jnp.exp(b_last - b), vc)
        return state, o

    init = jnp.zeros((B, H, F, V), q.dtype)
    _, o = lax.scan(step, init, (to_chunks(q), to_chunks(k), to_chunks(v), to_chunks(log_f)))
    return o.transpose(1, 0, 3, 2, 4).reshape(B, S, H, V)


def hgrn2_mixer(x, w_in, lower_bound, norm_g, w_out):
    B, S, D = x.shape
    zq, zf_fwd, zf_bwd, zi, zg = jnp.split(x @ w_in, 5, axis=-1)

    def heads(a, d):
        return a.reshape(B, S, HG_HEADS, d).astype(F32)

    q = jax.nn.silu(heads(zq, HG_F))
    i = heads(zi, HG_V)
    lb = lower_bound.astype(F32).reshape(2, HG_HEADS, HG_F)

    def gates(z, lb_d):
        zf = heads(z, HG_F)
        f = lb_d + (1.0 - lb_d) * jax.nn.sigmoid(zf)
        return (1.0 - lb_d) * jax.nn.sigmoid(-zf), jnp.log(f)

    k_f, lf_f = gates(zf_fwd, lb[0])
    k_b, lf_b = gates(zf_bwd, lb[1])
    o_fwd = hgrn2_chunk_scan(q, k_f, i, lf_f)
    rev = lambda a: jnp.flip(a, axis=1)
    o_bwd = rev(hgrn2_chunk_scan(rev(q), rev(k_b), rev(i), rev(lf_b)))
    o = o_fwd + o_bwd
    o = o * lax.rsqrt(jnp.mean(jnp.square(o), axis=-1, keepdims=True) + NORM_EPS)
    o = o * norm_g.astype(F32).reshape(HG_HEADS, HG_V) * jax.nn.silu(heads(zg, HG_V))
    return o.reshape(B, S, D).astype(x.dtype) @ w_out


def peer_ffn(x, w_q, sub_keys, u, v):
    B, S, D = x.shape
    q = (x @ w_q).reshape(B, S, PEER_HEADS, 2, PEER_DK // 2)
    s = jnp.einsum('bshcd,cnd->bshcn', q, sub_keys).astype(F32)
    sv, si = lax.top_k(s, PEER_TOPK)
    cand_s = (sv[..., 0, :, None] + sv[..., 1, None, :]).reshape(B, S, PEER_HEADS, PEER_TOPK * PEER_TOPK)
    cand_i = (si[..., 0, :, None] * PEER_NKEYS + si[..., 1, None, :]).reshape(B, S, PEER_HEADS, PEER_TOPK * PEER_TOPK)
    best_s, pos = lax.top_k(cand_s, PEER_TOPK)
    e_idx = jnp.take_along_axis(cand_i, pos, axis=-1)
    gate = jax.nn.softmax(best_s, axis=-1).astype(x.dtype)
    n_tok = B * S
    nb = n_tok // PEER_TOK_BLOCK
    e_per = PEER_HEADS * PEER_TOPK
    xb = x.reshape(nb, PEER_TOK_BLOCK, D)
    eb = e_idx.reshape(nb, PEER_TOK_BLOCK, e_per)
    gb = gate.reshape(nb, PEER_TOK_BLOCK, e_per)

    def block(args):
        xt, et, gt = args
        hid = jax.nn.gelu(jnp.einsum('td,ted->te', xt, u[et]), approximate=False)
        return jnp.einsum('te,ted->td', gt * hid, v[et])

    y = lax.map(block, (xb, eb, gb))
    return y.reshape(B, S, D)


def setup_inputs(seed: int = 0) -> dict:
    key = jax.random.key(seed)
    ks = jax.random.split(key, 24)
    nrm = lambda k, shape, scale: jax.random.normal(k, shape, F32) * scale
    D = D_MODEL
    return {
        'x': nrm(ks[0], (BATCH, SEQ, D), 1.0),
        'na_w_in': nrm(ks[1], (N_A, D, 3 * D), D ** -0.5),
        'na_rel_bias': nrm(ks[2], (N_A, NA_HEADS, 2 * NA_KH - 1, 2 * NA_KW - 1), 0.1),
        'na_w_out': nrm(ks[3], (N_A, D, D), DN_BETA * D ** -0.5),
        'mla_w_in': nrm(ks[4], (N_B, D, MLA_Q_RANK + MLA_KV_RANK + MLA_ROPE), D ** -0.5),
        'mla_q_norm': 1.0 + nrm(ks[5], (N_B, MLA_Q_RANK), 0.01),
        'mla_kv_norm': 1.0 + nrm(ks[6], (N_B, MLA_KV_RANK), 0.01),
        'mla_w_q_up': nrm(ks[7], (N_B, MLA_Q_RANK, MLA_HEADS * (MLA_NOPE + MLA_ROPE)), MLA_Q_RANK ** -0.5),
        'mla_w_kv_up': nrm(ks[8], (N_B, MLA_KV_RANK, MLA_HEADS * (MLA_NOPE + MLA_V)), MLA_KV_RANK ** -0.5),
        'mla_w_out': nrm(ks[9], (N_B, MLA_HEADS * MLA_V, D), DN_BETA * (MLA_HEADS * MLA_V) ** -0.5),
        'hg_w_in': nrm(ks[10], (N_C, D, 5 * D), D ** -0.5),
        'hg_lower_bound': nrm(ks[11], (DEPTH, 2, D), 0.1),
        'hg_norm': 1.0 + nrm(ks[12], (N_C, D), 0.01),
        'hg_w_out': nrm(ks[13], (N_C, D, D), DN_BETA * D ** -0.5),
        'peer_w_q': nrm(ks[14], (DEPTH, D, PEER_HEADS * PEER_DK), D ** -0.5),
        'peer_sub_keys': nrm(ks[15], (DEPTH, 2, PEER_NKEYS, PEER_DK // 2), (PEER_DK // 2) ** -0.5),
        'peer_u': nrm(ks[16], (DEPTH, PEER_EXPERTS, D), D ** -0.5),
        'peer_v': nrm(ks[17], (DEPTH, PEER_EXPERTS, D), DN_BETA * PEER_HEADS ** -0.5),
        'ln_mix_g': 1.0 + nrm(ks[18], (DEPTH, D), 0.01),
        'ln_mix_b': nrm(ks[19], (DEPTH, D), 0.01),
        'ln_ffn_g': 1.0 + nrm(ks[20], (DEPTH, D), 0.01),
        'ln_ffn_b': nrm(ks[21], (DEPTH, D), 0.01),
    }


def reference(x, na_w_in, na_rel_bias, na_w_out, mla_w_in, mla_q_norm, mla_kv_norm, mla_w_q_up, mla_w_kv_up, mla_w_out, hg_w_in, hg_lower_bound, hg_norm, hg_w_out, peer_w_q, peer_sub_keys, peer_u, peer_v, ln_mix_g, ln_mix_b, ln_ffn_g, ln_ffn_b):
    lb_w = jax.nn.softmax(hg_lower_bound.astype(F32), axis=0)
    lb_all = jnp.cumsum(lb_w, axis=0) - lb_w[0:1]
    h = x
    for layer in range(DEPTH):
        kind = layer % N_MIXERS
        j = layer // N_MIXERS
        if kind == 0:
            mix = neighborhood_attention(h, na_w_in[j], na_rel_bias[j], na_w_out[j])
        elif kind == 1:
            mix = mla_attention(h, mla_w_in[j], mla_q_norm[j], mla_kv_norm[j], mla_w_q_up[j], mla_w_kv_up[j], mla_w_out[j])
        else:
            mix = hgrn2_mixer(h, hg_w_in[j], lb_all[layer], hg_norm[j], hg_w_out[j])
        h = layer_norm(DN_ALPHA * h + mix, ln_mix_g[layer], ln_mix_b[layer])
        ffn = peer_ffn(h, peer_w_q[layer], peer_sub_keys[layer], peer_u[layer], peer_v[layer])
        h = layer_norm(DN_ALPHA * h + ffn, ln_ffn_g[layer], ln_ffn_b[layer])
    return h
```

```cpp
#include <hip/hip_runtime.h>
#include <hip/hip_cooperative_groups.h>
#include <stdint.h>
#include <cstdio>
namespace cg = cooperative_groups;

typedef unsigned short bf16;
using bf16x8 = __attribute__((ext_vector_type(8))) short;
using f32x4 = __attribute__((ext_vector_type(4))) float;

#define T_TOK 16384
#define SEQ 4096
#define DN_ALPHA 1.681792830507429f
#define NORM_EPS 1e-5f

constexpr size_t al256(size_t x) { return (x + 255) & ~(size_t)255; }
constexpr size_t SZ_NA_IN_T = (size_t)2 * 3072 * 1024 * 2;
constexpr size_t SZ_NA_OUT_T = (size_t)2 * 1024 * 1024 * 2;
constexpr size_t SZ_MLA_IN_T = (size_t)640 * 1024 * 2;
constexpr size_t SZ_MLA_QUP_T = (size_t)1536 * 256 * 2;
constexpr size_t SZ_MLA_KVUP_T = (size_t)2048 * 256 * 2;
constexpr size_t SZ_MLA_OUT_T = (size_t)1024 * 1024 * 2;
constexpr size_t SZ_HG_IN_T = (size_t)5120 * 1024 * 2;
constexpr size_t SZ_HG_OUT_T = (size_t)1024 * 1024 * 2;
constexpr size_t SZ_PEER_WQ_T = (size_t)4 * 2048 * 1024 * 2;
constexpr size_t SZ_PEER_KEYS = (size_t)4 * 2 * 128 * 128 * 2;
constexpr size_t SZ_UB = (size_t)4 * 16384 * 1024;
constexpr size_t SZ_USC = (size_t)4 * 16384 * 4;
constexpr size_t SZ_HF32 = (size_t)T_TOK * 1024 * 4;
constexpr size_t SZ_HBF = (size_t)T_TOK * 1024 * 2;
constexpr size_t SZ_R1 = (size_t)T_TOK * 5120 * 2;
constexpr size_t SZ_R2 = (size_t)T_TOK * 8 * 256 * 4;
constexpr size_t SZ_EIDX = (size_t)T_TOK * 128 * 4;
constexpr size_t SZ_DEC = (size_t)2048 * 2 * 128 * 4;
constexpr size_t SZ_LB = (size_t)2 * 1024 * 4;

constexpr size_t OFF_NA_IN_T = 0;
constexpr size_t OFF_NA_OUT_T = OFF_NA_IN_T + al256(SZ_NA_IN_T);
constexpr size_t OFF_MLA_IN_T = OFF_NA_OUT_T + al256(SZ_NA_OUT_T);
constexpr size_t OFF_MLA_QUP_T = OFF_MLA_IN_T + al256(SZ_MLA_IN_T);
constexpr size_t OFF_MLA_KVUP_T = OFF_MLA_QUP_T + al256(SZ_MLA_QUP_T);
constexpr size_t OFF_MLA_OUT_T = OFF_MLA_KVUP_T + al256(SZ_MLA_KVUP_T);
constexpr size_t OFF_HG_IN_T = OFF_MLA_OUT_T + al256(SZ_MLA_OUT_T);
constexpr size_t OFF_HG_OUT_T = OFF_HG_IN_T + al256(SZ_HG_IN_T);
constexpr size_t OFF_PEER_WQ_T = OFF_HG_OUT_T + al256(SZ_HG_OUT_T);
constexpr size_t OFF_PEER_KEYS = OFF_PEER_WQ_T + al256(SZ_PEER_WQ_T);
constexpr size_t OFF_UB = OFF_PEER_KEYS + al256(SZ_PEER_KEYS);
constexpr size_t OFF_VB = OFF_UB + al256(SZ_UB);
constexpr size_t OFF_HA = OFF_VB + al256(SZ_UB);
constexpr size_t OFF_HB = OFF_HA + al256(SZ_HF32);
constexpr size_t OFF_HBF = OFF_HB + al256(SZ_HF32);
constexpr size_t OFF_MIX = OFF_HBF + al256(SZ_HBF);
constexpr size_t OFF_R1 = OFF_MIX + al256(SZ_HF32);
constexpr size_t OFF_R2 = OFF_R1 + al256(SZ_R1);
constexpr size_t OFF_OBF = OFF_R2 + al256(SZ_R2);
constexpr size_t OFF_EIDX = OFF_OBF + al256(SZ_HBF);
constexpr size_t OFF_GATE = OFF_EIDX + al256(SZ_EIDX);
constexpr size_t OFF_VT = OFF_GATE + al256(SZ_EIDX);
constexpr size_t OFF_DEC = OFF_VT + al256(SZ_HBF);
constexpr size_t OFF_LB = OFF_DEC + al256(SZ_DEC);
constexpr size_t OFF_ROPE = OFF_LB + al256(SZ_LB);
constexpr size_t OFF_USC = OFF_ROPE + (size_t)2 * 4096 * 16 * 4;
constexpr size_t OFF_VSC = OFF_USC + al256(SZ_USC);
constexpr size_t OFF_BAR = OFF_VSC + al256(SZ_USC);
constexpr size_t WS_TOTAL = OFF_BAR + 16384;
static_assert(WS_TOTAL < ((size_t)1 << 30), "workspace must stay under 1 GiB");

struct Params {
  const float* in[22];
  float* out;
  char* ws;
};

typedef __bf16 hwbf2 __attribute__((ext_vector_type(2)));
typedef float hwf2 __attribute__((ext_vector_type(2)));
__device__ __forceinline__ unsigned pack2(float a, float b) {
  hwf2 v = {a, b};
  hwbf2 r = __builtin_convertvector(v, hwbf2);
  return __builtin_bit_cast(unsigned, r);
}
__device__ __forceinline__ bf16 f2bf(float f) { return (bf16)(pack2(f, 0.f) & 0xffffu); }
__device__ __forceinline__ float bf2f(bf16 h) { return __uint_as_float(((unsigned)h) << 16); }
__device__ __forceinline__ float bflo(unsigned w) { return __uint_as_float(w << 16); }
__device__ __forceinline__ float bfhi(unsigned w) { return __uint_as_float(w & 0xffff0000u); }
__device__ __forceinline__ int opaque_tid() {
  int t = threadIdx.x;
  asm volatile("" : "+v"(t));
  return t;
}
__device__ __forceinline__ int opaque_bid() {
  int b = blockIdx.x;
  asm volatile("" : "+s"(b));
  return b;
}
__device__ __forceinline__ float red_max_x32(float v) { const auto r = __builtin_amdgcn_permlane32_swap(__float_as_uint(v), __float_as_uint(v), false, false); return fmaxf(__uint_as_float(r[0]), __uint_as_float(r[1])); }
__device__ __forceinline__ float red_max_x16(float v) { const auto r = __builtin_amdgcn_permlane16_swap(__float_as_uint(v), __float_as_uint(v), false, false); return fmaxf(__uint_as_float(r[0]), __uint_as_float(r[1])); }
__device__ __forceinline__ float red_sum_x32(float v) { const auto r = __builtin_amdgcn_permlane32_swap(__float_as_uint(v), __float_as_uint(v), false, false); return __uint_as_float(r[0]) + __uint_as_float(r[1]); }
__device__ __forceinline__ float red_sum_x16(float v) { const auto r = __builtin_amdgcn_permlane16_swap(__float_as_uint(v), __float_as_uint(v), false, false); return __uint_as_float(r[0]) + __uint_as_float(r[1]); }
__device__ __forceinline__ float wave_sum(float v) {
  v = red_sum_x32(v);
  v = red_sum_x16(v);
  v += __int_as_float(__builtin_amdgcn_update_dpp(0, __float_as_int(v), 0x128, 0xF, 0xF, true));
  v += __int_as_float(__builtin_amdgcn_update_dpp(0, __float_as_int(v), 0xB1, 0xF, 0xF, true));
  v += __int_as_float(__builtin_amdgcn_update_dpp(0, __float_as_int(v), 0x4E, 0xF, 0xF, true));
  v += __int_as_float(__builtin_amdgcn_update_dpp(0, __float_as_int(v), 0x141, 0xF, 0xF, true));
  return v;
}
__device__ __forceinline__ float sigmoidf_(float x) { return __builtin_amdgcn_rcpf(1.0f + __expf(-x)); }
__device__ __forceinline__ f32x4 mfma16(bf16x8 a, bf16x8 b, f32x4 c) {
  return __builtin_amdgcn_mfma_f32_16x16x32_bf16(a, b, c, 0, 0, 0);
}
union U4B8 { uint4 u; bf16x8 v; };
__device__ __forceinline__ bf16x8 ld_frag16(const bf16* p) { U4B8 t; t.u = *(const uint4*)p; return t.v; }
__device__ __forceinline__ bf16x8 ld_frag8x2(const bf16* p0, const bf16* p1) {
  uint2 a = *(const uint2*)p0, b = *(const uint2*)p1;
  U4B8 t; t.u = make_uint4(a.x, a.y, b.x, b.y); return t.v;
}

__device__ void transpose_cvt(const float* __restrict__ src, bf16* __restrict__ dst, int K, int N, int Npad, char* smem) {
  float* tile = (float*)smem;
  const int tid = opaque_tid();
  const int bid_ = opaque_bid();
  const int tn_cnt = Npad >> 6, tk_cnt = K >> 6;
  const int ntiles = tn_cnt * tk_cnt;
  for (int t = bid_; t < ntiles; t += gridDim.x) {
    const int tk = t / tn_cnt, tn = t % tn_cnt;
    {
      const int j = tid & 63, i0 = tid >> 6;
      const int n = tn * 64 + j;
#pragma unroll 4
      for (int i = i0; i < 64; i += 4) {
        float v = (n < N) ? __builtin_nontemporal_load(src + (size_t)(tk * 64 + i) * N + n) : 0.0f;
        tile[i * 65 + j] = v;
      }
    }
    __syncthreads();
    {
      const int kk = tid & 63, n0 = tid >> 6;
#pragma unroll 4
      for (int nn = n0; nn < 64; nn += 4) {
        dst[(size_t)(tn * 64 + nn) * K + tk * 64 + kk] = f2bf(tile[kk * 65 + nn]);
      }
    }
    __syncthreads();
  }
}

__device__ void cvt_bf16(const float* __restrict__ src, bf16* __restrict__ dst, size_t n) {
  const size_t n8 = n >> 3;
  const size_t stride = (size_t)gridDim.x * 256;
  for (size_t i = (size_t)opaque_bid() * 256 + opaque_tid(); i < n8; i += stride) {
    float4 a = ((const float4*)src)[2 * i], b = ((const float4*)src)[2 * i + 1];
    uint4 o = make_uint4(pack2(a.x, a.y), pack2(a.z, a.w), pack2(b.x, b.y), pack2(b.z, b.w));
    ((uint4*)dst)[i] = o;
  }
}


__device__ void cvt_fp8_rows(const float* __restrict__ src, unsigned char* __restrict__ dst, float* __restrict__ isc, int nrows) {
  const int tid = opaque_tid();
  const int bid_ = opaque_bid();
  const int lane = tid & 63;
  const int gw = bid_ * 4 + (tid >> 6), nw = gridDim.x * 4;
  for (int row0 = gw * 2; row0 < nrows; row0 += nw * 2) {
    float4 v[2][4];
#pragma unroll
    for (int r = 0; r < 2; ++r)
#pragma unroll
      for (int c = 0; c < 4; ++c) {
        typedef float f4v_t __attribute__((ext_vector_type(4)));
        const f4v_t t_ = __builtin_nontemporal_load((const f4v_t*)(src + (size_t)(row0 + r) * 1024 + c * 256 + lane * 4));
        v[r][c] = make_float4(t_.x, t_.y, t_.z, t_.w);
      }
#pragma unroll
    for (int r = 0; r < 2; ++r) {
      float m = 0.f;
#pragma unroll
      for (int c = 0; c < 4; ++c) m = fmaxf(m, fmaxf(fmaxf(fabsf(v[r][c].x), fabsf(v[r][c].y)), fmaxf(fabsf(v[r][c].z), fabsf(v[r][c].w))));
#pragma unroll
      for (int o = 32; o >= 1; o >>= 1) m = fmaxf(m, __shfl_xor(m, o));
      const float sc = (m > 0.f) ? exp2f(floorf(log2f(240.0f / m))) : 1.0f;
#pragma unroll
      for (int c = 0; c < 4; ++c) {
        int wv = 0;
        wv = __builtin_amdgcn_cvt_pk_fp8_f32(v[r][c].x * sc, v[r][c].y * sc, wv, false);
        wv = __builtin_amdgcn_cvt_pk_fp8_f32(v[r][c].z * sc, v[r][c].w * sc, wv, true);
        *(int*)(dst + (size_t)(row0 + r) * 1024 + c * 256 + lane * 4) = wv;
      }
      if (lane == 0) isc[row0 + r] = 1.0f / sc;
    }
  }
}

struct EpiF32 {
  float* C; int ldc;
  __device__ __forceinline__ void operator()(int row, int col, f32x4 v) const {
#pragma unroll
    for (int j = 0; j < 4; ++j) C[(size_t)(row + j) * ldc + col] = v[j];
  }
};
struct EpiBF16 {
  bf16* C; int ldc;
  __device__ __forceinline__ void operator()(int row, int col, f32x4 v) const {
#pragma unroll
    for (int j = 0; j < 4; ++j) C[(size_t)(row + j) * ldc + col] = f2bf(v[j]);
  }
};
struct EpiNAqkv {
  bf16* qk; bf16* vt;
  __device__ __forceinline__ void operator()(int row, int col, f32x4 v) const {
    if (col < 2048) {
#pragma unroll
      for (int j = 0; j < 4; ++j) qk[(size_t)(row + j) * 2048 + col] = f2bf(v[j]);
    } else {
      const int c = col - 2048, head = c >> 6, d = c & 63, b = row >> 12, s = row & 4095;
      uint2 o = make_uint2(pack2(v[0], v[1]), pack2(v[2], v[3]));
      *(uint2*)(vt + ((size_t)((b * 16 + head) * 64 + d)) * SEQ + s) = o;
    }
  }
};
struct EpiMLAkv {
  bf16* kn; bf16* vt;
  __device__ __forceinline__ void operator()(int row, int col, f32x4 v) const {
    const int head = col >> 7, wi = col & 127, b = row >> 12, s = row & 4095;
    if (wi < 64) {
#pragma unroll
      for (int j = 0; j < 4; ++j) kn[((size_t)((b * 16 + head) * SEQ + s + j)) * 64 + wi] = f2bf(v[j]);
    } else {
      uint2 o = make_uint2(pack2(v[0], v[1]), pack2(v[2], v[3]));
      *(uint2*)(vt + ((size_t)((b * 16 + head) * 64 + (wi - 64))) * SEQ + s) = o;
    }
  }
};
struct EpiHGin {
  bf16* z; bf16* vt;
  __device__ __forceinline__ void operator()(int row, int col, f32x4 v) const {
#pragma unroll
    for (int j = 0; j < 4; ++j) z[(size_t)(row + j) * 5120 + col] = f2bf(v[j]);
    if (col >= 3072 && col < 4096) {
      const int c = col - 3072, head = c >> 7, vv = c & 127, b = row >> 12, s = row & 4095;
      uint2 o = make_uint2(pack2(v[0], v[1]), pack2(v[2], v[3]));
      *(uint2*)(vt + ((size_t)((b * 8 + head) * 128 + vv)) * SEQ + s) = o;
    }
  }
};

#define GEMM_LDS_STRIDE 40
template <int NT, class Epi>
__device__ __forceinline__ void gemm_bt(const bf16* __restrict__ A, int lda, const bf16* __restrict__ Bt, int ldb,
                                        int M, int N, int K, const Epi& epi, char* smem) {
  constexpr int BN = 32 * NT;
  constexpr int NB = BN / 64;
  const int tid = opaque_tid(), lane = tid & 63, w = tid >> 6;
  const int bid_ = opaque_bid();
  const int wm = w >> 1, wn = w & 1;
  const int g = lane >> 4, r16 = lane & 15;
  bf16* sA = (bf16*)smem;
  bf16* sB = sA + 2 * 128 * GEMM_LDS_STRIDE;
  const int tilesN = N / BN;
  const int ntiles = (M >> 7) * tilesN;
  const int nk = K >> 5;
  const int lrow = tid >> 2, lkc = (tid & 3) * 8;
  const bool xsw = ((gridDim.x & 7) == 0) && (((M >> 7) & 7) == 0);
  const int t_first = xsw ? (bid_ >> 3) : bid_;
  const int t_step = xsw ? (int)(gridDim.x >> 3) : (int)gridDim.x;
  const int t_cnt = xsw ? (ntiles >> 3) : ntiles;
  for (int tq = t_first; tq < t_cnt; tq += t_step) {
    const int rbq = tq / tilesN;
    const int m0 = (xsw ? (rbq * 8 + (bid_ & 7)) : rbq) << 7, n0 = (tq % tilesN) * BN;
    f32x4 acc[4][NT];
#pragma unroll
    for (int i = 0; i < 4; ++i)
#pragma unroll
      for (int j = 0; j < NT; ++j) acc[i][j] = (f32x4){0.f, 0.f, 0.f, 0.f};
    const bf16* gA = A + (size_t)(m0 + lrow) * lda + lkc;
    const bf16* gB = Bt + (size_t)(n0 + lrow) * ldb + lkc;
    uint4 ra0, ra1, rb0, rb1, rb2, rb3;
#define GEMM_GLOAD(KO) do { \
      ra0 = *(const uint4*)(gA + (KO)); ra1 = *(const uint4*)(gA + (size_t)64 * lda + (KO)); \
      rb0 = *(const uint4*)(gB + (KO)); rb1 = *(const uint4*)(gB + (size_t)64 * ldb + (KO)); \
      if constexpr (NB == 4) { rb2 = *(const uint4*)(gB + (size_t)128 * ldb + (KO)); rb3 = *(const uint4*)(gB + (size_t)192 * ldb + (KO)); } } while (0)
#define GEMM_LSTORE(BUF) do { \
      bf16* dA_ = sA + (BUF) * 128 * GEMM_LDS_STRIDE + lrow * GEMM_LDS_STRIDE + lkc; \
      bf16* dB_ = sB + (BUF) * BN * GEMM_LDS_STRIDE + lrow * GEMM_LDS_STRIDE + lkc; \
      *(uint4*)dA_ = ra0; *(uint4*)(dA_ + 64 * GEMM_LDS_STRIDE) = ra1; \
      *(uint4*)dB_ = rb0; *(uint4*)(dB_ + 64 * GEMM_LDS_STRIDE) = rb1; \
      if constexpr (NB == 4) { *(uint4*)(dB_ + 128 * GEMM_LDS_STRIDE) = rb2; *(uint4*)(dB_ + 192 * GEMM_LDS_STRIDE) = rb3; } } while (0)
    GEMM_GLOAD(0);
    GEMM_LSTORE(0);
    __syncthreads();
    for (int kt = 0; kt < nk; ++kt) {
      const int cur = kt & 1;
      if (kt + 1 < nk) GEMM_GLOAD((kt + 1) * 32);
      const bf16* a_base = sA + cur * 128 * GEMM_LDS_STRIDE + (wm * 64 + r16) * GEMM_LDS_STRIDE + g * 8;
      const bf16* b_base = sB + cur * BN * GEMM_LDS_STRIDE + (wn * (16 * NT) + r16) * GEMM_LDS_STRIDE + g * 8;
      bf16x8 af[4];
#pragma unroll
      for (int i = 0; i < 4; ++i) af[i] = ld_frag16(a_base + i * 16 * GEMM_LDS_STRIDE);
#pragma unroll
      for (int jh = 0; jh < NT / 4; ++jh) {
        bf16x8 bfr[4];
#pragma unroll
        for (int j = 0; j < 4; ++j) bfr[j] = ld_frag16(b_base + (jh * 4 + j) * 16 * GEMM_LDS_STRIDE);
        __builtin_amdgcn_s_setprio(1);
#pragma unroll
        for (int i = 0; i < 4; ++i)
#pragma unroll
          for (int j = 0; j < 4; ++j) acc[i][jh * 4 + j] = mfma16(af[i], bfr[j], acc[i][jh * 4 + j]);
        __builtin_amdgcn_s_setprio(0);
      }
      if (kt + 1 < nk) GEMM_LSTORE(cur ^ 1);
      __syncthreads();
    }
#pragma unroll
    for (int i = 0; i < 4; ++i)
#pragma unroll
      for (int j = 0; j < NT; ++j) epi(m0 + wm * 64 + i * 16 + g * 4, n0 + wn * (16 * NT) + j * 16 + r16, acc[i][j]);
  }
}

__device__ void ln_phase(const float* __restrict__ hin, const float* __restrict__ mix, const float* __restrict__ gam,
                         const float* __restrict__ bet, float* __restrict__ hout, bf16* __restrict__ hbf) {
  const int tid = opaque_tid();
  const int bid_ = opaque_bid();
  const int lane = tid & 63;
  const int gw = bid_ * 4 + (tid >> 6), nw = gridDim.x * 4;
  for (int row = gw; row < T_TOK; row += nw) {
    float v[16];
    float s = 0.f;
#pragma unroll
    for (int c = 0; c < 4; ++c) {
      const size_t o = (size_t)row * 1024 + c * 256 + lane * 4;
      typedef float f4v_t __attribute__((ext_vector_type(4)));
      const f4v_t a_ = __builtin_nontemporal_load((const f4v_t*)(hin + o)), m_ = __builtin_nontemporal_load((const f4v_t*)(mix + o));
      const float4 a = make_float4(a_.x, a_.y, a_.z, a_.w), m = make_float4(m_.x, m_.y, m_.z, m_.w);
      v[c * 4 + 0] = DN_ALPHA * a.x + m.x; v[c * 4 + 1] = DN_ALPHA * a.y + m.y;
      v[c * 4 + 2] = DN_ALPHA * a.z + m.z; v[c * 4 + 3] = DN_ALPHA * a.w + m.w;
      s += v[c * 4 + 0] + v[c * 4 + 1] + v[c * 4 + 2] + v[c * 4 + 3];
    }
    const float mu = wave_sum(s) * (1.0f / 1024.0f);
    float q = 0.f;
#pragma unroll
    for (int i = 0; i < 16; ++i) { float d = v[i] - mu; q += d * d; }
    const float rstd = rsqrtf(wave_sum(q) * (1.0f / 1024.0f) + NORM_EPS);
#pragma unroll
    for (int c = 0; c < 4; ++c) {
      const int col = c * 256 + lane * 4;
      float4 gg = *(const float4*)(gam + col), bb = *(const float4*)(bet + col);
      float4 o;
      o.x = (v[c * 4 + 0] - mu) * rstd * gg.x + bb.x; o.y = (v[c * 4 + 1] - mu) * rstd * gg.y + bb.y;
      o.z = (v[c * 4 + 2] - mu) * rstd * gg.z + bb.z; o.w = (v[c * 4 + 3] - mu) * rstd * gg.w + bb.w;
      *(float4*)(hout + (size_t)row * 1024 + col) = o;
      *(uint2*)(hbf + (size_t)row * 1024 + col) = make_uint2(pack2(o.x, o.y), pack2(o.z, o.w));
    }
  }
}

__device__ void na_attn_phase(const bf16* __restrict__ qk, const bf16* __restrict__ vt, const float* __restrict__ rel_bias,
                              bf16* __restrict__ o, char* smem) {
  const int tid = opaque_tid();
  const int bid_ = opaque_bid();
  const int lane = tid & 63, w = tid >> 6, g = lane >> 4, r16 = lane & 15;
  const int s0 = (w == 0) ? 0 : (w == 1) ? 8 : (w == 2) ? 24 : 32;
  const int wq = 16 * w + r16;
  const int c0 = min(max(wq - 8, 0), 48);
  const bool xsw = (gridDim.x & 7) == 0;
  const int i_first = xsw ? (bid_ >> 3) : bid_;
  const int i_step = xsw ? (int)(gridDim.x >> 3) : (int)gridDim.x;
  const int i_cnt = xsw ? 512 : 4096;
  for (int iq = i_first; iq < i_cnt; iq += i_step) {
    const int item = xsw ? (((((iq >> 6) << 3) + (bid_ & 7)) << 6) + (iq & 63)) : iq;
    const int pair_ = xsw ? (item >> 6) : (((item >> 10) << 4) | (item & 15));
    const int head = pair_ & 15, r = xsw ? (item & 63) : ((item >> 4) & 63), b = pair_ >> 4;
    const int r0 = min(max(r - 4, 0), 56);
    float* sb = (float*)smem;
    __syncthreads();
    for (int i = tid; i < 480; i += 256) {
      const int rr = i >> 5, cc = i & 31;
      sb[i] = (cc < 31) ? rel_bias[(head * 15 + rr) * 31 + cc] * 1.4426950408889634f : 0.f;
    }
    __syncthreads();
    const int tq = b * SEQ + r * 64 + wq;
    bf16x8 qf[2];
#pragma unroll
    for (int ks = 0; ks < 2; ++ks) qf[ks] = ld_frag16(qk + (size_t)tq * 2048 + head * 64 + ks * 32 + g * 8);
    f32x4 st[8][2];
#pragma unroll
    for (int kr2 = 0; kr2 < 4; ++kr2) {
      bf16x8 ka[8];
#pragma unroll
      for (int q = 0; q < 8; ++q) {
        const int kr = kr2 * 2 + (q >> 2), kt = (q >> 1) & 1, ks = q & 1;
        const int tk = b * SEQ + (r0 + kr) * 64 + s0 + 8 * (r16 >> 2) + 4 * kt + (r16 & 3);
        ka[q] = ld_frag16(qk + (size_t)tk * 2048 + 1024 + head * 64 + ks * 32 + g * 8);
      }
      __builtin_amdgcn_sched_barrier(0);
#pragma unroll
      for (int q = 0; q < 8; q += 2) {
        const int kr = kr2 * 2 + (q >> 2), kt = (q >> 1) & 1;
        f32x4 acc = (f32x4){0.f, 0.f, 0.f, 0.f};
        acc = mfma16(ka[q], qf[0], acc);
        acc = mfma16(ka[q + 1], qf[1], acc);
        st[kr][kt] = acc;
      }
      __builtin_amdgcn_sched_barrier(0);
    }
    float mx = -INFINITY;
#pragma unroll
    for (int kr = 0; kr < 8; ++kr)
#pragma unroll
      for (int kt = 0; kt < 2; ++kt)
#pragma unroll
        for (int jj = 0; jj < 4; ++jj) {
          const int kc = s0 + 8 * g + 4 * kt + jj;
          const bool valid = (kc >= c0) && (kc < c0 + 16);
          const int dr = r0 + kr - r + 7;
          const int dc = min(max(kc - wq + 15, 0), 30);
          float bias = sb[dr * 32 + dc];
          asm volatile("" : "+v"(bias));
          const float val = valid ? fmaf(st[kr][kt][jj], 0.125f * 1.4426950408889634f, bias) : -INFINITY;
          st[kr][kt][jj] = val;
          mx = fmaxf(mx, val);
        }
    mx = red_max_x16(mx);
    mx = red_max_x32(mx);
    float sum = 0.f;
#pragma unroll
    for (int kr = 0; kr < 8; ++kr)
#pragma unroll
      for (int kt = 0; kt < 2; ++kt)
#pragma unroll
        for (int jj = 0; jj < 4; ++jj) {
          const float pv = __builtin_amdgcn_exp2f(st[kr][kt][jj] - mx);
          st[kr][kt][jj] = pv;
          sum += pv;
        }
    sum = red_sum_x16(sum);
    sum = red_sum_x32(sum);
    f32x4 oacc[4];
#pragma unroll
    for (int dt = 0; dt < 4; ++dt) oacc[dt] = (f32x4){0.f, 0.f, 0.f, 0.f};
#pragma unroll
    for (int kr2 = 0; kr2 < 4; ++kr2) {
      bf16x8 va[8];
#pragma unroll
      for (int q = 0; q < 8; ++q) {
        const int kr = kr2 * 2 + (q >> 2), dt = q & 3;
        va[q] = ld_frag16(vt + ((size_t)((b * 16 + head) * 64 + dt * 16 + r16)) * SEQ + (r0 + kr) * 64 + s0 + 8 * g);
      }
      __builtin_amdgcn_sched_barrier(0);
#pragma unroll
      for (int q = 0; q < 8; ++q) {
        const int kr = kr2 * 2 + (q >> 2), dt = q & 3;
        U4B8 pb;
        pb.u = make_uint4(pack2(st[kr][0][0], st[kr][0][1]), pack2(st[kr][0][2], st[kr][0][3]),
                          pack2(st[kr][1][0], st[kr][1][1]), pack2(st[kr][1][2], st[kr][1][3]));
        oacc[dt] = mfma16(va[q], pb.v, oacc[dt]);
      }
      __builtin_amdgcn_sched_barrier(0);
    }
    const float inv = 1.0f / sum;
#pragma unroll
    for (int dt = 0; dt < 4; ++dt) {
      uint2 ov = make_uint2(pack2(oacc[dt][0] * inv, oacc[dt][1] * inv), pack2(oacc[dt][2] * inv, oacc[dt][3] * inv));
      *(uint2*)(o + (size_t)tq * 1024 + head * 64 + dt * 16 + 4 * g) = ov;
    }
  }
}

__device__ void mla_prep_phase(const float* __restrict__ hin  , const float* __restrict__ rope, const float* __restrict__ qn, const float* __restrict__ kvn,
                               bf16* __restrict__ cqn, bf16* __restrict__ ckvn, bf16* __restrict__ kpe) {
  const int tid = opaque_tid();
  const int bid_ = opaque_bid();
  const int lane = tid & 63;
  const int gw = bid_ * 4 + (tid >> 6), nw = gridDim.x * 4;
  for (int t = gw; t < T_TOK; t += nw) {
    const float* row = hin + (size_t)t * 640;
    typedef float f4v_t __attribute__((ext_vector_type(4)));
    const f4v_t a_ = __builtin_nontemporal_load((const f4v_t*)(row + lane * 4)), c_ = __builtin_nontemporal_load((const f4v_t*)(row + 256 + lane * 4));
    float4 a = make_float4(a_.x, a_.y, a_.z, a_.w);
    float4 c = make_float4(c_.x, c_.y, c_.z, c_.w);
    float sa = wave_sum(a.x * a.x + a.y * a.y + a.z * a.z + a.w * a.w);
    float sc = wave_sum(c.x * c.x + c.y * c.y + c.z * c.z + c.w * c.w);
    const float ra = rsqrtf(sa * (1.0f / 256.0f) + NORM_EPS), rc = rsqrtf(sc * (1.0f / 256.0f) + NORM_EPS);
    float4 ga = *(const float4*)(qn + lane * 4), gc = *(const float4*)(kvn + lane * 4);
    *(uint2*)(cqn + (size_t)t * 256 + lane * 4) = make_uint2(pack2(a.x * ra * ga.x, a.y * ra * ga.y), pack2(a.z * ra * ga.z, a.w * ra * ga.w));
    *(uint2*)(ckvn + (size_t)t * 256 + lane * 4) = make_uint2(pack2(c.x * rc * gc.x, c.y * rc * gc.y), pack2(c.z * rc * gc.z, c.w * rc * gc.w));
    if (lane < 16) {
      const float x1 = row[512 + lane], x2 = row[528 + lane];
      const float cs = rope[(t & 4095) * 16 + lane], sn = rope[4096 * 16 + (t & 4095) * 16 + lane];
      kpe[(size_t)t * 32 + lane] = f2bf(x1 * cs - x2 * sn);
      kpe[(size_t)t * 32 + 16 + lane] = f2bf(x1 * sn + x2 * cs);
    }
  }
}

#define MLA_KS 104
#define MLA_VS 72
__device__ void mla_attn_phase(const bf16* __restrict__ q  , const bf16* __restrict__ kn  ,
                               const bf16* __restrict__ kpe  , const bf16* __restrict__ vt  ,
                               bf16* __restrict__ o  , const float* __restrict__ rope, char* smem) {
  const int tid = opaque_tid(), lane = tid & 63, w = tid >> 6, g = lane >> 4, r16 = lane & 15;
  const int bid_ = opaque_bid();
  bf16* sK = (bf16*)smem;
  bf16* sV = sK + 2 * 64 * MLA_KS;
  const float sc2 = 0.10206207261596575f * 1.4426950408889634f;
  const bool xsw = (gridDim.x & 7) == 0;
  const int i_first = xsw ? (bid_ >> 3) : bid_;
  const int i_step = xsw ? (int)(gridDim.x >> 3) : (int)gridDim.x;
  const int i_cnt = xsw ? 256 : 2048;
  for (int iq = i_first; iq < i_cnt; iq += i_step) {
    const int item = xsw ? (((((iq >> 5) << 3) + (bid_ & 7)) << 5) + (iq & 31)) : iq;
    const int qb = item & 31, head = (item >> 5) & 15, b = item >> 9;
    const int bh = b * 16 + head;
    bf16x8 qf[2][3];
#pragma unroll
    for (int qt = 0; qt < 2; ++qt) {
      const int tq = b * SEQ + qb * 128 + w * 32 + qt * 16 + r16;
      const bf16* qrow = q + (size_t)tq * 1536 + head * 96;
      qf[qt][0] = ld_frag16(qrow + g * 8);
      qf[qt][1] = ld_frag16(qrow + 32 + g * 8);
      const int i0 = 8 * (g & 1);
      uint4 x1r = *(const uint4*)(qrow + 64 + i0), x2r = *(const uint4*)(qrow + 80 + i0);
      const unsigned x1w[4] = {x1r.x, x1r.y, x1r.z, x1r.w}, x2w[4] = {x2r.x, x2r.y, x2r.z, x2r.w};
      float res[8];
      const float* cp = rope + (tq & 4095) * 16 + i0;
      const float4 c0 = *(const float4*)cp, c1 = *(const float4*)(cp + 4);
      const float4 s0 = *(const float4*)(cp + 4096 * 16), s1 = *(const float4*)(cp + 4096 * 16 + 4);
      const float csv[8] = {c0.x, c0.y, c0.z, c0.w, c1.x, c1.y, c1.z, c1.w};
      const float snv[8] = {s0.x, s0.y, s0.z, s0.w, s1.x, s1.y, s1.z, s1.w};
#pragma unroll
      for (int j = 0; j < 8; ++j) {
        const float x1 = (j & 1) ? bfhi(x1w[j >> 1]) : bflo(x1w[j >> 1]);
        const float x2 = (j & 1) ? bfhi(x2w[j >> 1]) : bflo(x2w[j >> 1]);
        res[j] = (g < 2) ? (x1 * csv[j] - x2 * snv[j]) : (x1 * snv[j] + x2 * csv[j]);
      }
      U4B8 t; t.u = make_uint4(pack2(res[0], res[1]), pack2(res[2], res[3]), pack2(res[4], res[5]), pack2(res[6], res[7]));
      qf[qt][2] = t.v;
    }
    uint4 rk0, rk1, rk2, rv0, rv1;
    const bf16* kn_b = kn + (size_t)bh * SEQ * 64;
    const bf16* kpe_b = kpe + (size_t)b * SEQ * 32;
    const bf16* vt_b = vt + (size_t)bh * 64 * SEQ;
    const unsigned ko = (unsigned)tid * 8u;
    const unsigned vo0 = (unsigned)(tid >> 3) * SEQ + (unsigned)(tid & 7) * 8u;
    const unsigned vo1 = vo0 + 32u * SEQ;
    auto gload = [&](int kt) {
      const bf16* kb = kn_b + (size_t)kt * 64 * 64;
      const bf16* pb_ = kpe_b + (size_t)kt * 64 * 32;
      const bf16* vb_ = vt_b + (size_t)kt * 64;
      asm volatile("" : "+s"(kb), "+s"(pb_), "+s"(vb_));
      typedef unsigned v4u_t __attribute__((ext_vector_type(4)));
      typedef const v4u_t __attribute__((address_space(1))) * gp_t;
      const v4u_t t0 = *(gp_t)(kb + ko), t1 = *(gp_t)(kb + ko + 2048u), t2 = *(gp_t)(pb_ + ko), t3 = *(gp_t)(vb_ + vo0), t4 = *(gp_t)(vb_ + vo1);
      rk0 = make_uint4(t0.x, t0.y, t0.z, t0.w); rk1 = make_uint4(t1.x, t1.y, t1.z, t1.w); rk2 = make_uint4(t2.x, t2.y, t2.z, t2.w);
      rv0 = make_uint4(t3.x, t3.y, t3.z, t3.w); rv1 = make_uint4(t4.x, t4.y, t4.z, t4.w);
    };
    auto lstore = [&](int buf) {
      bf16* dk = sK + buf * 64 * MLA_KS;
      *(uint4*)(dk + (tid >> 3) * MLA_KS + (tid & 7) * 8) = rk0;
      *(uint4*)(dk + (32 + (tid >> 3)) * MLA_KS + (tid & 7) * 8) = rk1;
      *(uint4*)(dk + (tid >> 2) * MLA_KS + 64 + (tid & 3) * 8) = rk2;
      bf16* dv = sV + buf * 64 * MLA_VS;
      *(uint4*)(dv + (tid >> 3) * MLA_VS + (tid & 7) * 8) = rv0;
      *(uint4*)(dv + (32 + (tid >> 3)) * MLA_VS + (tid & 7) * 8) = rv1;
    };
    gload(0);
    lstore(0);
    __syncthreads();
    float m_[2] = {-INFINITY, -INFINITY}, l_[2] = {0.f, 0.f};
    f32x4 oacc[2][4];
#pragma unroll
    for (int qt = 0; qt < 2; ++qt)
#pragma unroll
      for (int dt = 0; dt < 4; ++dt) oacc[qt][dt] = (f32x4){0.f, 0.f, 0.f, 0.f};
#pragma unroll 1
    for (int kt = 0; kt < 64; ++kt) {
      const int cur = kt & 1;
      if (kt + 1 < 64) gload(kt + 1);
      f32x4 s[2][4];
#pragma unroll
      for (int qt = 0; qt < 2; ++qt)
#pragma unroll
        for (int k4 = 0; k4 < 4; ++k4) s[qt][k4] = (f32x4){0.f, 0.f, 0.f, 0.f};
      __builtin_amdgcn_s_setprio(1);
#pragma unroll
      for (int k4 = 0; k4 < 4; ++k4)
#pragma unroll
        for (int ks = 0; ks < 3; ++ks) {
          bf16x8 a = ld_frag16(sK + cur * 64 * MLA_KS + (32 * (k4 >> 1) + 8 * (r16 >> 2) + 4 * (k4 & 1) + (r16 & 3)) * MLA_KS + ks * 32 + g * 8);
#pragma unroll
          for (int qt = 0; qt < 2; ++qt) s[qt][k4] = mfma16(a, qf[qt][ks], s[qt][k4]);
        }
      __builtin_amdgcn_s_setprio(0);
      bf16x8 pb[2][2];
#pragma unroll
      for (int qt = 0; qt < 2; ++qt) {
        float mx = -INFINITY;
#pragma unroll
        for (int k4 = 0; k4 < 4; ++k4)
#pragma unroll
          for (int jj = 0; jj < 4; ++jj) mx = fmaxf(mx, s[qt][k4][jj]);
        mx = red_max_x16(mx);
        mx = red_max_x32(mx);
        const float mxs = mx * sc2;
        if (__builtin_amdgcn_ballot_w64(mxs > m_[qt] + 11.541560327111707f) != 0ull) {
          const float mnew = fmaxf(m_[qt], mxs);
          const float alpha = __builtin_amdgcn_exp2f(m_[qt] - mnew);
          m_[qt] = mnew;
          l_[qt] *= alpha;
#pragma unroll
          for (int dt = 0; dt < 4; ++dt)
#pragma unroll
            for (int jj = 0; jj < 4; ++jj) oacc[qt][dt][jj] *= alpha;
        }
        const float mcur = m_[qt];
        float ps = 0.f;
#pragma unroll
        for (int k4 = 0; k4 < 4; ++k4)
#pragma unroll
          for (int jj = 0; jj < 4; ++jj) { const float pv = __builtin_amdgcn_exp2f(fmaf(s[qt][k4][jj], sc2, -mcur)); s[qt][k4][jj] = pv; ps += pv; }
        l_[qt] += ps;
#pragma unroll
        for (int kk = 0; kk < 2; ++kk) {
          U4B8 t;
          t.u = make_uint4(pack2(s[qt][2 * kk][0], s[qt][2 * kk][1]), pack2(s[qt][2 * kk][2], s[qt][2 * kk][3]),
                           pack2(s[qt][2 * kk + 1][0], s[qt][2 * kk + 1][1]), pack2(s[qt][2 * kk + 1][2], s[qt][2 * kk + 1][3]));
          pb[qt][kk] = t.v;
        }
      }
      __builtin_amdgcn_s_setprio(1);
#pragma unroll
      for (int dt = 0; dt < 4; ++dt)
#pragma unroll
        for (int kk = 0; kk < 2; ++kk) {
          const bf16* base = sV + cur * 64 * MLA_VS + (dt * 16 + r16) * MLA_VS + kk * 32 + 8 * g;
          bf16x8 a = ld_frag16(base);
#pragma unroll
          for (int qt = 0; qt < 2; ++qt) oacc[qt][dt] = mfma16(a, pb[qt][kk], oacc[qt][dt]);
        }
      __builtin_amdgcn_s_setprio(0);
      if (kt + 1 < 64) lstore(cur ^ 1);
      __syncthreads();
    }
#pragma unroll
    for (int qt = 0; qt < 2; ++qt) {
      float ls = l_[qt];
      ls = red_sum_x16(ls);
      ls = red_sum_x32(ls);
      const float inv = 1.0f / ls;
      const int tq = b * SEQ + qb * 128 + w * 32 + qt * 16 + r16;
#pragma unroll
      for (int dt = 0; dt < 4; ++dt) {
        uint2 ov = make_uint2(pack2(oacc[qt][dt][0] * inv, oacc[qt][dt][1] * inv), pack2(oacc[qt][dt][2] * inv, oacc[qt][dt][3] * inv));
        *(uint2*)(o + (size_t)tq * 1024 + head * 64 + dt * 16 + 4 * g) = ov;
      }
    }
  }
}

#define HG_KS 72
#define HG_QS 136
#define HG_AS 72
__device__ void hg_local_phase(const bf16* __restrict__ z, const bf16* __restrict__ vt, const float* __restrict__ lbv,
                               bf16* __restrict__ local, float* __restrict__ dec, char* smem) {
  const int tid = opaque_tid(), lane = tid & 63, w = tid >> 6, g = lane >> 4, r16 = lane & 15;
  const int bid_ = opaque_bid();
  bf16* sZ = (bf16*)smem;
  bf16* sKl = sZ + 64 * HG_QS;
  float* sTot = (float*)(sKl + 128 * HG_KS);
  for (int item = bid_; item < 2048; item += gridDim.x) {
    const int n = item & 63, hd = (item >> 6) & 7, b = item >> 9;
    const int tok0 = b * SEQ + n * 64;
#pragma unroll 1
    for (int dir = 0; dir < 2; ++dir) {
#pragma unroll
      for (int i = 0; i < 4; ++i) {
        const int c = tid + 256 * i, row = c >> 4, cc = c & 15;
        *(uint4*)(sZ + row * HG_QS + cc * 8) = *(const uint4*)(z + (size_t)(tok0 + row) * 5120 + (1 + dir) * 1024 + hd * 128 + cc * 8);
      }
      __syncthreads();
      {
        const int f = tid & 127, half = tid >> 7, hbase = half * 32;
        const int first = dir ? 0 : 1;
        const float lb = lbv[dir * 1024 + hd * 128 + f];
        float lfv[32];
        float tot = 0.f;
#pragma unroll
        for (int i = 0; i < 32; ++i) {
          const int t = dir ? (hbase + i) : (hbase + 31 - i);
          const float zf = bf2f(sZ[t * HG_QS + f]);
          const float sg = sigmoidf_(zf);
          lfv[i] = __logf(lb + (1.0f - lb) * sg);
          tot += lfv[i];
        }
        sTot[half * 128 + f] = tot;
        __syncthreads();
        float run = (half == first) ? 0.f : sTot[first * 128 + f];
#pragma unroll
        for (int i = 0; i < 32; ++i) {
          const int t = dir ? (hbase + i) : (hbase + 31 - i);
          sKl[f * HG_KS + t] = f2bf((1.0f - __expf(lfv[i])) * __expf(run));
          run += lfv[i];
        }
        if (half != first) dec[(size_t)(item * 2 + dir) * 128 + f] = __expf(run);
      }
      __syncthreads();
      f32x4 acc[2][8];
#pragma unroll
      for (int fi = 0; fi < 2; ++fi)
#pragma unroll
        for (int v8 = 0; v8 < 8; ++v8) acc[fi][v8] = (f32x4){0.f, 0.f, 0.f, 0.f};
#pragma unroll
      for (int kk = 0; kk < 2; ++kk) {
        bf16x8 a[2];
#pragma unroll
        for (int fi = 0; fi < 2; ++fi) a[fi] = ld_frag16(sKl + ((2 * w + fi) * 16 + r16) * HG_KS + kk * 32 + g * 8);
#pragma unroll
        for (int v8 = 0; v8 < 8; ++v8) {
          bf16x8 bb = ld_frag16(vt + ((size_t)((b * 8 + hd) * 128 + v8 * 16 + r16)) * SEQ + n * 64 + kk * 32 + g * 8);
#pragma unroll
          for (int fi = 0; fi < 2; ++fi) acc[fi][v8] = mfma16(a[fi], bb, acc[fi][v8]);
        }
      }
      bf16* lp = local + (size_t)(item * 2 + dir) * 16384;
#pragma unroll
      for (int fi = 0; fi < 2; ++fi)
#pragma unroll
        for (int v8 = 0; v8 < 8; ++v8) {
          uint2 o = make_uint2(pack2(acc[fi][v8][0], acc[fi][v8][1]), pack2(acc[fi][v8][2], acc[fi][v8][3]));
          *(uint2*)(lp + (v8 * 16 + r16) * 128 + (2 * w + fi) * 16 + 4 * g) = o;
        }
      __syncthreads();
    }
  }
}
__device__ void hg_prefix_phase(bf16* __restrict__ local, const float* __restrict__ dec) {
  const int total = 64 * 2048;
  for (int idx = opaque_bid() * 256 + opaque_tid(); idx < total; idx += gridDim.x * 256) {
    const int chain = idx >> 11, e8 = idx & 2047;
    const int bh = chain >> 1, dir = chain & 1;
    const int f0 = (e8 * 8) & 127;
    float r[8];
#pragma unroll
    for (int j = 0; j < 8; ++j) r[j] = 0.f;
#pragma unroll 8
    for (int i = 0; i < 64; ++i) {
      const int n = dir ? 63 - i : i;
      const size_t idn = (size_t)((bh * 64 + n) * 2 + dir);
      uint4* ptr = (uint4*)(local + idn * 16384 + (size_t)e8 * 8);
      typedef unsigned u4v_t __attribute__((ext_vector_type(4)));
      const u4v_t raw_ = __builtin_nontemporal_load((const u4v_t*)ptr);
      const uint4 raw = make_uint4(raw_.x, raw_.y, raw_.z, raw_.w);
      const float4 d0 = *(const float4*)(dec + idn * 128 + f0), d1 = *(const float4*)(dec + idn * 128 + f0 + 4);
      *ptr = make_uint4(pack2(r[0], r[1]), pack2(r[2], r[3]), pack2(r[4], r[5]), pack2(r[6], r[7]));
      r[0] = d0.x * r[0] + bflo(raw.x); r[1] = d0.y * r[1] + bfhi(raw.x);
      r[2] = d0.z * r[2] + bflo(raw.y); r[3] = d0.w * r[3] + bfhi(raw.y);
      r[4] = d1.x * r[4] + bflo(raw.z); r[5] = d1.y * r[5] + bfhi(raw.z);
      r[6] = d1.z * r[6] + bflo(raw.w); r[7] = d1.w * r[7] + bfhi(raw.w);
    }
  }
}
__device__ void hg_out_phase(const bf16* __restrict__ z, const bf16* __restrict__ vt, const float* __restrict__ lbv,
                             const bf16* __restrict__ state, const float* __restrict__ normg, bf16* __restrict__ og, char* smem) {
  const int tid = opaque_tid(), lane = tid & 63, w = tid >> 6, g = lane >> 4, r16 = lane & 15;
  const int bid_ = opaque_bid();
  bf16* sQ = (bf16*)smem;
  bf16* sKd = sQ + 64 * HG_QS;
  bf16* sAt = sKd + 64 * HG_QS;
  float* sTot = (float*)(sAt + 64 * HG_AS);
  for (int item = bid_; item < 2048; item += gridDim.x) {
    const int n = item & 63, hd = (item >> 6) & 7, b = item >> 9;
    const int tok0 = b * SEQ + n * 64;
    f32x4 oacc[8];
#pragma unroll
    for (int v8 = 0; v8 < 8; ++v8) oacc[v8] = (f32x4){0.f, 0.f, 0.f, 0.f};
#pragma unroll 1
    for (int dir = 0; dir < 2; ++dir) {
#pragma unroll
      for (int i = 0; i < 4; ++i) {
        const int c = tid + 256 * i, row = c >> 4, cc = c & 15;
        const bf16* zr = z + (size_t)(tok0 + row) * 5120 + hd * 128 + cc * 8;
        *(uint4*)(sQ + row * HG_QS + cc * 8) = *(const uint4*)zr;
        *(uint4*)(sKd + row * HG_QS + cc * 8) = *(const uint4*)(zr + (1 + dir) * 1024);
      }
      __syncthreads();
      {
        const int f = tid & 127, half = tid >> 7, hbase = half * 32;
        const int first = dir ? 1 : 0;
        const float lb = lbv[dir * 1024 + hd * 128 + f];
        float lfv[32];
        float tot = 0.f;
#pragma unroll
        for (int i = 0; i < 32; ++i) {
          const int t = dir ? (hbase + 31 - i) : (hbase + i);
          const float zf = bf2f(sKd[t * HG_QS + f]);
          const float sg = sigmoidf_(zf);
          lfv[i] = __logf(lb + (1.0f - lb) * sg);
          tot += lfv[i];
        }
        sTot[half * 128 + f] = tot;
        __syncthreads();
        float run = (half == first) ? 0.f : sTot[first * 128 + f];
#pragma unroll
        for (int i = 0; i < 32; ++i) {
          const int t = dir ? (hbase + 31 - i) : (hbase + i);
          run += lfv[i];
          const float zz = bf2f(sQ[t * HG_QS + f]);
          const float qv = zz * sigmoidf_(zz);
          sQ[t * HG_QS + f] = f2bf(qv * __expf(run));
          sKd[t * HG_QS + f] = f2bf((1.0f - __expf(lfv[i])) * __expf(-run));
        }
      }
      __syncthreads();
      {
        f32x4 a4[4];
#pragma unroll
        for (int st = 0; st < 4; ++st) a4[st] = (f32x4){0.f, 0.f, 0.f, 0.f};
#pragma unroll
        for (int kk = 0; kk < 4; ++kk) {
          bf16x8 a = ld_frag16(sQ + (16 * w + r16) * HG_QS + kk * 32 + g * 8);
#pragma unroll
          for (int st = 0; st < 4; ++st) {
            bf16x8 bb = ld_frag16(sKd + (16 * st + r16) * HG_QS + kk * 32 + g * 8);
            a4[st] = mfma16(a, bb, a4[st]);
          }
        }
#pragma unroll
        for (int st = 0; st < 4; ++st)
#pragma unroll
          for (int jj = 0; jj < 4; ++jj) {
            const int t = 16 * w + 4 * g + jj, s = 16 * st + r16;
            const bool keep = dir ? (s >= t) : (s <= t);
            sAt[t * HG_AS + s] = f2bf(keep ? a4[st][jj] : 0.f);
          }
      }
      __syncthreads();
#pragma unroll 1
      for (int kk = 0; kk < 2; ++kk) {
        bf16x8 a = ld_frag16(sAt + (16 * w + r16) * HG_AS + kk * 32 + g * 8);
        bf16x8 bb[8];
#pragma unroll
        for (int v8 = 0; v8 < 8; ++v8) bb[v8] = ld_frag16(vt + ((size_t)((b * 8 + hd) * 128 + v8 * 16 + r16)) * SEQ + n * 64 + kk * 32 + g * 8);
        __builtin_amdgcn_sched_barrier(0);
#pragma unroll
        for (int v8 = 0; v8 < 8; ++v8) oacc[v8] = mfma16(a, bb[v8], oacc[v8]);
        __builtin_amdgcn_sched_barrier(0);
      }
      const bf16* sp = state + (size_t)(item * 2 + dir) * 16384;
#pragma unroll 1
      for (int kk = 0; kk < 4; ++kk) {
        bf16x8 a = ld_frag16(sQ + (16 * w + r16) * HG_QS + kk * 32 + g * 8);
        bf16x8 bb[8];
#pragma unroll
        for (int v8 = 0; v8 < 8; ++v8) bb[v8] = ld_frag16(sp + (v8 * 16 + r16) * 128 + kk * 32 + g * 8);
        __builtin_amdgcn_sched_barrier(0);
#pragma unroll
        for (int v8 = 0; v8 < 8; ++v8) oacc[v8] = mfma16(a, bb[v8], oacc[v8]);
        __builtin_amdgcn_sched_barrier(0);
      }
      __syncthreads();
    }
    float rs[4];
#pragma unroll
    for (int jj = 0; jj < 4; ++jj) {
      float ss = 0.f;
#pragma unroll
      for (int v8 = 0; v8 < 8; ++v8) ss += oacc[v8][jj] * oacc[v8][jj];
      ss += __shfl_xor(ss, 1); ss += __shfl_xor(ss, 2); ss += __shfl_xor(ss, 4); ss += __shfl_xor(ss, 8);
      rs[jj] = rsqrtf(ss * (1.0f / 128.0f) + NORM_EPS);
    }
    {
      bf16 zgr[8][4];
#pragma unroll
      for (int v8 = 0; v8 < 8; ++v8)
#pragma unroll
        for (int jj = 0; jj < 4; ++jj)
          zgr[v8][jj] = z[(size_t)(tok0 + 16 * w + 4 * g + jj) * 5120 + 4096 + hd * 128 + v8 * 16 + r16];
      __builtin_amdgcn_sched_barrier(0);
#pragma unroll
      for (int v8 = 0; v8 < 8; ++v8) {
        const int col = hd * 128 + v8 * 16 + r16;
        const float ng = normg[col];
#pragma unroll
        for (int jj = 0; jj < 4; ++jj) {
          const int t = tok0 + 16 * w + 4 * g + jj;
          const float zg = bf2f(zgr[v8][jj]);
          const float val = oacc[v8][jj] * rs[jj] * ng * (zg * sigmoidf_(zg));
          og[(size_t)t * 1024 + col] = f2bf(val);
        }
      }
    }
  }
}

__device__ __forceinline__ void topk128(const bf16* __restrict__ sp, float (&top)[16]) {
#pragma unroll
  for (int p = 0; p < 16; ++p) top[p] = -INFINITY;
#pragma unroll 1
  for (int c8 = 0; c8 < 2; ++c8) {
    uint4 vv[8];
#pragma unroll
    for (int c = 0; c < 8; ++c) vv[c] = *(const uint4*)(sp + (c8 * 8 + c) * 8);
    __builtin_amdgcn_sched_barrier(0);
#pragma unroll
    for (int c = 0; c < 8; ++c) {
      const unsigned wv[4] = {vv[c].x, vv[c].y, vv[c].z, vv[c].w};
#pragma unroll
      for (int e = 0; e < 8; ++e) {
        const unsigned hbits = (e & 1) ? (wv[e >> 1] & 0xffff0000u) : (wv[e >> 1] << 16);
        const float x = __uint_as_float(hbits | (unsigned)((c8 * 8 + c) * 8 + e));
#pragma unroll
        for (int p = 15; p >= 1; --p) top[p] = __builtin_amdgcn_fmed3f(top[p - 1], top[p], x);
        top[0] = fmaxf(top[0], x);
      }
    }
  }
}
__device__ void peer_topk_phase(const bf16* __restrict__ s  , int* __restrict__ eidx, float* __restrict__ gate) {
  for (int idx = opaque_bid() * 256 + opaque_tid(); idx < T_TOK * 8; idx += gridDim.x * 256) {
    float t0[16], t1[16];
    topk128(s + (size_t)idx * 256, t0);
    topk128(s + (size_t)idx * 256 + 128, t1);
    float bs[16]; int be[16];
#pragma unroll
    for (int p = 0; p < 16; ++p) { bs[p] = -INFINITY; be[p] = 0; }
#pragma unroll
    for (int i = 0; i < 16; ++i)
#pragma unroll
      for (int j = 0; j < 16; ++j) {
        if ((i + 1) * (j + 1) <= 16) {
          const unsigned u0 = __float_as_uint(t0[i]), u1 = __float_as_uint(t1[j]);
          float x = __uint_as_float(u0 & ~127u) + __uint_as_float(u1 & ~127u);
          int xe = (int)((u0 & 127u) * 128u + (u1 & 127u));
#pragma unroll
          for (int p = 0; p < 16; ++p) {
            const bool c = x > bs[p];
            const float tv = c ? bs[p] : x;
            const int te = c ? be[p] : xe;
            bs[p] = c ? x : bs[p];
            be[p] = c ? xe : be[p];
            x = tv; xe = te;
          }
        }
      }
    float wgt[16], sum = 0.f;
#pragma unroll
    for (int p = 0; p < 16; ++p) { wgt[p] = __expf(bs[p] - bs[0]); sum += wgt[p]; }
    const float inv = 1.0f / sum;
#pragma unroll
    for (int p4 = 0; p4 < 4; ++p4) {
      *(int4*)(eidx + (size_t)idx * 16 + p4 * 4) = make_int4(be[p4 * 4], be[p4 * 4 + 1], be[p4 * 4 + 2], be[p4 * 4 + 3]);
      *(float4*)(gate + (size_t)idx * 16 + p4 * 4) = make_float4(wgt[p4 * 4] * inv, wgt[p4 * 4 + 1] * inv, wgt[p4 * 4 + 2] * inv, wgt[p4 * 4 + 3] * inv);
    }
  }
}

typedef float float2v __attribute__((ext_vector_type(2)));
__device__ __forceinline__ float dot16_fp8(int4 r, const float* x) {
  const int wv[4] = {r.x, r.y, r.z, r.w};
  float2v acc = {0.f, 0.f};
#pragma unroll
  for (int i = 0; i < 4; ++i) {
    const float2v lo = __builtin_amdgcn_cvt_pk_f32_fp8(wv[i], false);
    const float2v hi = __builtin_amdgcn_cvt_pk_f32_fp8(wv[i], true);
    const float2v x0 = {x[4 * i], x[4 * i + 1]}, x1 = {x[4 * i + 2], x[4 * i + 3]};
    acc = __builtin_elementwise_fma(lo, x0, acc);
    acc = __builtin_elementwise_fma(hi, x1, acc);
  }
  return acc.x + acc.y;
}
__device__ __forceinline__ void axpy16_fp8(float c, int4 r, float* y) {
  const int wv[4] = {r.x, r.y, r.z, r.w};
#pragma unroll
  for (int i = 0; i < 4; ++i) {
    const float2v lo = __builtin_amdgcn_cvt_pk_f32_fp8(wv[i], false);
    const float2v hi = __builtin_amdgcn_cvt_pk_f32_fp8(wv[i], true);
    y[4 * i] += c * lo.x; y[4 * i + 1] += c * lo.y; y[4 * i + 2] += c * hi.x; y[4 * i + 3] += c * hi.y;
  }
}
__device__ __forceinline__ int4 ld_row16(const unsigned char* rowp, unsigned loff) {
  asm volatile("" : "+s"(rowp));
  typedef int v4i_t __attribute__((ext_vector_type(4)));
  typedef const v4i_t __attribute__((address_space(1))) * gp_t;
  const v4i_t v = *(gp_t)(rowp + loff);
  return make_int4(v.x, v.y, v.z, v.w);
}
__device__ void peer_gather_phase(const float* __restrict__ h1, const unsigned char* __restrict__ ub, const unsigned char* __restrict__ vb,
                                  const float* __restrict__ usc, const float* __restrict__ vsc,
                                  const int* __restrict__ eidx, const float* __restrict__ gate, const float* __restrict__ gam,
                                  const float* __restrict__ bet, float* __restrict__ hout, bf16* __restrict__ hbf, char* smem) {
  const int tid = opaque_tid();
  const int bid_ = opaque_bid();
  const int lane = tid & 63;
  const int gw = bid_ * 4 + (tid >> 6), nw = gridDim.x * 4;
  const unsigned loff = (unsigned)lane * 16u;
  const int esel = lane >> 3;
  int* se = (int*)(smem + (tid >> 6) * 2048);
  float* sg = (float*)(se + 128);
  float* sc = sg + 128;
  for (int t = gw; t < T_TOK; t += nw) {
    float x[16], y[16];
    {
      const float* xr = h1 + (size_t)t * 1024 + lane * 16;
      float4 a0 = *(const float4*)xr, a1 = *(const float4*)(xr + 4), a2 = *(const float4*)(xr + 8), a3 = *(const float4*)(xr + 12);
      x[0] = a0.x; x[1] = a0.y; x[2] = a0.z; x[3] = a0.w; x[4] = a1.x; x[5] = a1.y; x[6] = a1.z; x[7] = a1.w;
      x[8] = a2.x; x[9] = a2.y; x[10] = a2.z; x[11] = a2.w; x[12] = a3.x; x[13] = a3.y; x[14] = a3.z; x[15] = a3.w;
    }
    int ereg0, ereg1;
    float gv0, gv1, iu0, iu1;
    {
      const int e0 = eidx[(size_t)t * 128 + lane], e1 = eidx[(size_t)t * 128 + 64 + lane];
      const float g0 = gate[(size_t)t * 128 + lane], g1 = gate[(size_t)t * 128 + 64 + lane];
      const int b0 = e0 >> 11, b1 = e1 >> 11;
      int rk0 = 0, rk1 = 0, base = 0;
#pragma unroll
      for (int bk = 0; bk < 8; ++bk) {
        const unsigned long long m0 = __ballot(b0 == bk), m1 = __ballot(b1 == bk);
        const int c0 = __popcll(m0), c1 = __popcll(m1);
        const int p0 = __builtin_amdgcn_mbcnt_hi((unsigned)(m0 >> 32), __builtin_amdgcn_mbcnt_lo((unsigned)m0, 0u));
        const int p1 = __builtin_amdgcn_mbcnt_hi((unsigned)(m1 >> 32), __builtin_amdgcn_mbcnt_lo((unsigned)m1, 0u));
        rk0 = (b0 == bk) ? (base + p0) : rk0;
        rk1 = (b1 == bk) ? (base + c0 + p1) : rk1;
        base += c0 + c1;
      }
      se[rk0] = e0; se[rk1] = e1; sg[rk0] = g0; sg[rk1] = g1;
      __builtin_amdgcn_fence(__ATOMIC_RELEASE, "wavefront");
      __builtin_amdgcn_wave_barrier();
      __builtin_amdgcn_fence(__ATOMIC_ACQUIRE, "wavefront");
      ereg0 = se[lane]; ereg1 = se[64 + lane];
      gv0 = sg[lane] * vsc[ereg0]; gv1 = sg[64 + lane] * vsc[ereg1];
      iu0 = usc[ereg0]; iu1 = usc[ereg1];
      __builtin_amdgcn_wave_barrier();
    }
#define G_LDROWS(DST, TBL, BT) do { const int es_ = ((BT) < 8) ? ereg0 : ereg1; const int eb_ = ((BT) & 7) * 8; \
      _Pragma("unroll") for (int k = 0; k < 8; ++k) { const int id_ = __builtin_amdgcn_readlane(es_, eb_ + k); DST[k] = ld_row16(TBL + (size_t)id_ * 1024, loff); } } while (0)
#define G_PASS1(SRC, BT) do { const int eb_ = ((BT) & 7) * 8; \
      float d_[8]; \
      _Pragma("unroll") for (int k = 0; k < 8; ++k) d_[k] = dot16_fp8(SRC[k], x); \
      float q4_[4], q2_[2], q1_; \
      _Pragma("unroll") for (int k = 0; k < 4; ++k) { \
        const auto r_ = __builtin_amdgcn_permlane32_swap(__float_as_uint(d_[k]), __float_as_uint(d_[k + 4]), false, false); \
        q4_[k] = __uint_as_float(r_[0]) + __uint_as_float(r_[1]); } \
      _Pragma("unroll") for (int k = 0; k < 2; ++k) { \
        const auto r_ = __builtin_amdgcn_permlane16_swap(__float_as_uint(q4_[k]), __float_as_uint(q4_[k + 2]), false, false); \
        q2_[k] = __uint_as_float(r_[0]) + __uint_as_float(r_[1]); } \
      { const bool hi_ = (lane & 8) != 0; const float keep_ = hi_ ? q2_[1] : q2_[0]; const float send_ = hi_ ? q2_[0] : q2_[1]; \
        q1_ = keep_ + __int_as_float(__builtin_amdgcn_update_dpp(0, __float_as_int(send_), 0x128, 0xF, 0xF, true)); } \
      q1_ += __int_as_float(__builtin_amdgcn_update_dpp(0, __float_as_int(q1_), 0xB1, 0xF, 0xF, true)); \
      q1_ += __int_as_float(__builtin_amdgcn_update_dpp(0, __float_as_int(q1_), 0x4E, 0xF, 0xF, true)); \
      q1_ += __int_as_float(__builtin_amdgcn_update_dpp(0, __float_as_int(q1_), 0x141, 0xF, 0xF, true)); \
      ddacc = ((((BT) & 7) == (lane & 7))) ? q1_ : ddacc; } while (0)
#define G_FINISH_HALF(HALF) do { const int slot_ = 8 * (lane & 7) + (lane >> 3); \
      const float dd_ = ddacc * __shfl((HALF) ? iu1 : iu0, slot_); \
      const float hid_ = 0.5f * dd_ * (1.0f + erff(dd_ * 0.7071067811865476f)); \
      sc[(HALF) * 64 + slot_] = hid_ * __shfl((HALF) ? gv1 : gv0, slot_); } while (0)
    float ddacc = 0.f;
    {
      int4 rA[8], rB[8];
      G_LDROWS(rA, ub, 0);
      __builtin_amdgcn_sched_barrier(0);
#pragma unroll 1
      for (int bt = 0; bt < 16; bt += 2) {
        G_LDROWS(rB, ub, bt + 1);
        __builtin_amdgcn_sched_barrier(0);
        G_PASS1(rA, bt);
        __builtin_amdgcn_sched_barrier(0);
        if (bt + 2 < 16) G_LDROWS(rA, ub, bt + 2);
        __builtin_amdgcn_sched_barrier(0);
        G_PASS1(rB, bt + 1);
        if (((bt + 1) & 7) == 7) G_FINISH_HALF(bt >> 3);
        __builtin_amdgcn_sched_barrier(0);
      }
    }
    __builtin_amdgcn_fence(__ATOMIC_RELEASE, "wavefront");
    __builtin_amdgcn_wave_barrier();
    __builtin_amdgcn_fence(__ATOMIC_ACQUIRE, "wavefront");
    const float cf0 = sc[lane], cf1 = sc[64 + lane];
    __builtin_amdgcn_wave_barrier();
#pragma unroll
    for (int i = 0; i < 16; ++i) y[i] = 0.f;
#define G_PASS2(SRC, BT) do { const int eb_ = ((BT) & 7) * 8; const int cs_ = __float_as_int(((BT) < 8) ? cf0 : cf1); \
      _Pragma("unroll") for (int k = 0; k < 8; ++k) { const float c_ = __int_as_float(__builtin_amdgcn_readlane(cs_, eb_ + k)); axpy16_fp8(c_, SRC[k], y); } } while (0)
    {
      int4 rA[8];
#pragma unroll 1
      for (int bt = 0; bt < 16; ++bt) {
        G_LDROWS(rA, vb, bt);
        __builtin_amdgcn_sched_barrier(0);
        G_PASS2(rA, bt);
        __builtin_amdgcn_sched_barrier(0);
      }
    }
    {
      const float* xr = h1 + (size_t)t * 1024 + lane * 16;
      float4 a0 = *(const float4*)xr, a1 = *(const float4*)(xr + 4), a2 = *(const float4*)(xr + 8), a3 = *(const float4*)(xr + 12);
      asm volatile("" : "+v"(a0.x), "+v"(a1.x), "+v"(a2.x), "+v"(a3.x));
      x[0] = a0.x; x[1] = a0.y; x[2] = a0.z; x[3] = a0.w; x[4] = a1.x; x[5] = a1.y; x[6] = a1.z; x[7] = a1.w;
      x[8] = a2.x; x[9] = a2.y; x[10] = a2.z; x[11] = a2.w; x[12] = a3.x; x[13] = a3.y; x[14] = a3.z; x[15] = a3.w;
    }
    float sm = 0.f;
#pragma unroll
    for (int i = 0; i < 16; ++i) { y[i] = DN_ALPHA * x[i] + y[i]; sm += y[i]; }
    const float mu = wave_sum(sm) * (1.0f / 1024.0f);
    float qq = 0.f;
#pragma unroll
    for (int i = 0; i < 16; ++i) { const float dd = y[i] - mu; qq += dd * dd; }
    const float rstd = rsqrtf(wave_sum(qq) * (1.0f / 1024.0f) + NORM_EPS);
    const int col = lane * 16;
    float o[16];
#pragma unroll
    for (int c4 = 0; c4 < 4; ++c4) {
      const float4 g0 = *(const float4*)(gam + col + c4 * 4), b0 = *(const float4*)(bet + col + c4 * 4);
      o[c4 * 4 + 0] = (y[c4 * 4 + 0] - mu) * rstd * g0.x + b0.x; o[c4 * 4 + 1] = (y[c4 * 4 + 1] - mu) * rstd * g0.y + b0.y;
      o[c4 * 4 + 2] = (y[c4 * 4 + 2] - mu) * rstd * g0.z + b0.z; o[c4 * 4 + 3] = (y[c4 * 4 + 3] - mu) * rstd * g0.w + b0.w;
      *(float4*)(hout + (size_t)t * 1024 + col + c4 * 4) = make_float4(o[c4 * 4], o[c4 * 4 + 1], o[c4 * 4 + 2], o[c4 * 4 + 3]);
    }
    *(uint4*)(hbf + (size_t)t * 1024 + col) = make_uint4(pack2(o[0], o[1]), pack2(o[2], o[3]), pack2(o[4], o[5]), pack2(o[6], o[7]));
    *(uint4*)(hbf + (size_t)t * 1024 + col + 8) = make_uint4(pack2(o[8], o[9]), pack2(o[10], o[11]), pack2(o[12], o[13]), pack2(o[14], o[15]));
  }
}

#define XB_TMO      128
#define XB_XCNT(j)  (256  + 64 * (j))
#define XB_XSUB(j)  (1280 + 64 * (j))
#define XB_XGEN(j)  (2304 + 64 * (j))
#define XB_TOP      3328
#define XB_TOPGEN   3392
#define XCD_BAR_WORDS 3456
#define XB_SPIN_CAP (1u << 22)
#define LAS __attribute__((address_space(3)))
__device__ __forceinline__ unsigned xb_ld(unsigned* p) { return __hip_atomic_load(p, __ATOMIC_RELAXED, __HIP_MEMORY_SCOPE_AGENT); }
__device__ __forceinline__ unsigned xb_add(unsigned* p, unsigned v) { return __hip_atomic_fetch_add(p, v, __ATOMIC_RELAXED, __HIP_MEMORY_SCOPE_AGENT); }
__device__ __forceinline__ unsigned xb_xcc_id() { return (unsigned)__builtin_amdgcn_s_getreg((3 << 11) | 20) & 0xFu; }
#define XB_SPIN(cond, bar) do { unsigned _sp = 0; while (cond) { __builtin_amdgcn_s_sleep(1); \
    if ((++_sp & 255u) == 0u) { if (xb_ld(&(bar)[XB_TMO])) break; if (_sp > XB_SPIN_CAP) { atomicAdd(&(bar)[XB_TMO], 1u); break; } } } } while (0)
struct XcdBarrier { unsigned* bar; unsigned x; volatile LAS unsigned* st; };
__device__ __forceinline__ XcdBarrier xcd_barrier_post(unsigned* bar, volatile LAS unsigned* st) {
  XcdBarrier b; b.bar = bar; b.x = xb_xcc_id(); b.st = st;
  if (threadIdx.x == 0) (void)xb_add(&bar[XB_XCNT(b.x)], 1u);
  return b;
}
__device__ __forceinline__ void xcd_barrier_complete(unsigned* bar, unsigned x, unsigned& nloc, unsigned& nx) {
  const unsigned G = gridDim.x * gridDim.y * gridDim.z;
  unsigned sum, cnt, mine, sp = 0u;
  for (;;) {
    sum = 0u; cnt = 0u; mine = 0u;
#pragma unroll
    for (unsigned j = 0; j < 16; ++j) { const unsigned c = xb_ld(&bar[XB_XCNT(j)]); sum += c; cnt += (c > 0u) ? 1u : 0u; mine = (j == x) ? c : mine; }
    if (sum == G) break;
    __builtin_amdgcn_s_sleep(1);
    if ((++sp & 255u) == 0u) { if (xb_ld(&bar[XB_TMO])) break; if (sp > XB_SPIN_CAP) { atomicAdd(&bar[XB_TMO], 1u); break; } }
  }
  nloc = mine > 0u ? mine : 1u; nx = cnt > 0u ? cnt : 1u;
}
__device__ __forceinline__ void xcd_barrier(const XcdBarrier& b) {
  asm volatile("s_waitcnt vmcnt(0)" ::: "memory");
  __syncthreads();
  if (threadIdx.x == 0) {
    unsigned* bar = b.bar;
    asm volatile("" : "+s"(bar));
    __builtin_amdgcn_s_waitcnt(0);
    unsigned nloc = b.st[0], nx = b.st[1];
    if (nloc == 0u) { xcd_barrier_complete(bar, b.x, nloc, nx); b.st[0] = nloc; b.st[1] = nx; }
    const unsigned old = xb_add(&bar[XB_XSUB(b.x)], 1u);
    const unsigned gen = old / nloc;
    if (old + 1u == (gen + 1u) * nloc) {
      __builtin_amdgcn_fence(__ATOMIC_RELEASE, "agent");
      asm volatile("s_waitcnt vmcnt(0)" ::: "memory");
      const unsigned og = xb_add(&bar[XB_TOP], 1u);
      const unsigned tg = og / nx;
      if (og + 1u == (tg + 1u) * nx) xb_add(&bar[XB_TOPGEN], 1u);
      else XB_SPIN(xb_ld(&bar[XB_TOPGEN]) == tg, bar);
      __builtin_amdgcn_fence(__ATOMIC_ACQUIRE, "agent");
      xb_add(&bar[XB_XGEN(b.x)], 1u);
      asm volatile("s_waitcnt vmcnt(0)" ::: "memory");
    } else {
      XB_SPIN(xb_ld(&bar[XB_XGEN(b.x)]) == gen, bar);
      __builtin_amdgcn_fence(__ATOMIC_ACQUIRE, "agent");
      asm volatile("s_waitcnt vmcnt(0)" ::: "memory");
    }
  }
  __syncthreads();
}

#define SMEM_BYTES 61440
__global__ void __launch_bounds__(256, 2) mega_kernel(Params p) {
  __shared__ __attribute__((aligned(16))) char smem[SMEM_BYTES + 16];
  cg::grid_group grid = cg::this_grid();
  char* ws = p.ws;
  bf16* na_in_t = (bf16*)(ws + OFF_NA_IN_T);
  bf16* na_out_t = (bf16*)(ws + OFF_NA_OUT_T);
  bf16* mla_in_t = (bf16*)(ws + OFF_MLA_IN_T);
  bf16* mla_qup_t = (bf16*)(ws + OFF_MLA_QUP_T);
  bf16* mla_kvup_t = (bf16*)(ws + OFF_MLA_KVUP_T);
  bf16* mla_out_t = (bf16*)(ws + OFF_MLA_OUT_T);
  bf16* hg_in_t = (bf16*)(ws + OFF_HG_IN_T);
  bf16* hg_out_t = (bf16*)(ws + OFF_HG_OUT_T);
  bf16* peer_wq_t = (bf16*)(ws + OFF_PEER_WQ_T);
  bf16* peer_keys = (bf16*)(ws + OFF_PEER_KEYS);
  unsigned char* ub = (unsigned char*)(ws + OFF_UB);
  unsigned char* vb = (unsigned char*)(ws + OFF_VB);
  float* usc = (float*)(ws + OFF_USC);
  float* vsc = (float*)(ws + OFF_VSC);
  float* hA = (float*)(ws + OFF_HA);
  float* hB = (float*)(ws + OFF_HB);
  bf16* hbf = (bf16*)(ws + OFF_HBF);
  float* mix = (float*)(ws + OFF_MIX);
  char* R1 = ws + OFF_R1;
  char* R2 = ws + OFF_R2;
  bf16* obf = (bf16*)(ws + OFF_OBF);
  int* eidx = (int*)(ws + OFF_EIDX);
  float* gate = (float*)(ws + OFF_GATE);
  bf16* vtb = (bf16*)(ws + OFF_VT);
  float* dec = (float*)(ws + OFF_DEC);
  float* lbv = (float*)(ws + OFF_LB);
  float* ropet = (float*)(ws + OFF_ROPE);
  unsigned* bar = (unsigned*)(ws + OFF_BAR);
  if (threadIdx.x == 0) *(uint4*)(smem + SMEM_BYTES) = make_uint4(0u, 0u, 0u, 0u);
  __syncthreads();
  XcdBarrier xb = xcd_barrier_post(bar, (volatile LAS unsigned*)(smem + SMEM_BYTES));

  if (gridDim.x == 0x7fffffffu) grid.sync();

#pragma unroll 1
  for (int layer = 0; layer < 4; ++layer) {
    const int kind = layer % 3;
    const int j = layer / 3;
    const float* hin = (layer == 0) ? p.in[0] : hB;
    bf16* qk = (bf16*)R1;
    float* hmla = (float*)R1;
    bf16* qb = (bf16*)(R1 + (size_t)T_TOK * 640 * 4);
    bf16* knb = qb + (size_t)T_TOK * 1536;
    bf16* cqn = (bf16*)R2;
    bf16* ckvn = cqn + (size_t)T_TOK * 256;
    bf16* kpe = ckvn + (size_t)T_TOK * 256;
    bf16* z = (bf16*)R1;
    bf16* local = (bf16*)R2;
    bf16* pq = (bf16*)R1;
    bf16* psb = (bf16*)R2;
#pragma unroll 1
    for (int sub = (layer == 0) ? -1 : 0; sub < 10; ++sub) {
      bool did = true;
      switch (sub) {
        case -1: {
      #pragma unroll 1
        for (int job = 0; job < 14; ++job) {
          const float* src; bf16* dst; int K = 1024, N = 1024, Np = 1024;
          switch (job) {
            case 0: case 1: src = p.in[1] + (size_t)job * 1024 * 3072; dst = na_in_t + (size_t)job * 3072 * 1024; N = 3072; Np = 3072; break;
            case 2: case 3: src = p.in[3] + (size_t)(job - 2) * 1024 * 1024; dst = na_out_t + (size_t)(job - 2) * 1024 * 1024; break;
            case 4: src = p.in[4]; dst = mla_in_t; N = 544; Np = 640; break;
            case 5: src = p.in[7]; dst = mla_qup_t; K = 256; N = 1536; Np = 1536; break;
            case 6: src = p.in[8]; dst = mla_kvup_t; K = 256; N = 2048; Np = 2048; break;
            case 7: src = p.in[9]; dst = mla_out_t; break;
            case 8: src = p.in[10]; dst = hg_in_t; N = 5120; Np = 5120; break;
            case 9: src = p.in[13]; dst = hg_out_t; break;
            default: src = p.in[14] + (size_t)(job - 10) * 1024 * 2048; dst = peer_wq_t + (size_t)(job - 10) * 2048 * 1024; N = 2048; Np = 2048; break;
          }
          transpose_cvt(src, dst, K, N, Np, smem);
        }
        cvt_bf16(p.in[15], peer_keys, (size_t)4 * 2 * 128 * 128);
        cvt_fp8_rows(p.in[16], ub, usc, 4 * 16384);
        cvt_fp8_rows(p.in[17], vb, vsc, 4 * 16384);
        cvt_bf16(p.in[0], hbf, (size_t)T_TOK * 1024);
        for (int i = opaque_bid() * 256 + opaque_tid(); i < 4096 * 16; i += gridDim.x * 256) {
          const float invf = powf(10000.0f, -(float)(i & 15) * (1.0f / 16.0f));
          const float ang = (float)(i >> 4) * invf;
          ropet[i] = cosf(ang);
          ropet[4096 * 16 + i] = sinf(ang);
        }
        {
          const float* lbp = p.in[11];
          for (int i = opaque_bid() * 256 + opaque_tid(); i < 2048; i += gridDim.x * 256) {
            float a0 = lbp[i], a1 = lbp[2048 + i], a2 = lbp[4096 + i], a3 = lbp[6144 + i];
            float mx = fmaxf(fmaxf(a0, a1), fmaxf(a2, a3));
            float e0 = expf(a0 - mx), e1 = expf(a1 - mx), e2 = expf(a2 - mx), e3 = expf(a3 - mx);
            lbv[i] = (e1 + e2) / (e0 + e1 + e2 + e3);
          }
        }
        } break;
        case 0:
          if (kind == 0) gemm_bt<8>(hbf, 1024, na_in_t + (size_t)j * 3072 * 1024, 1024, T_TOK, 3072, 1024, EpiNAqkv{qk, vtb}, smem);
          else if (kind == 1) gemm_bt<4>(hbf, 1024, mla_in_t, 1024, T_TOK, 640, 1024, EpiF32{hmla, 640}, smem);
          else gemm_bt<8>(hbf, 1024, hg_in_t, 1024, T_TOK, 5120, 1024, EpiHGin{z, vtb}, smem);
          break;
        case 1:
          if (kind == 0) na_attn_phase(qk, vtb, p.in[2] + (size_t)j * 16 * 15 * 31, obf, smem);
          else if (kind == 1) mla_prep_phase(hmla, ropet, p.in[5], p.in[6], cqn, ckvn, kpe);
          else hg_local_phase(z, vtb, lbv, local, dec, smem);
          break;
        case 2:
          if (kind == 1) {
            gemm_bt<8>(cqn, 256, mla_qup_t, 256, T_TOK, 1536, 256, EpiBF16{qb, 1536}, smem);
            gemm_bt<8>(ckvn, 256, mla_kvup_t, 256, T_TOK, 2048, 256, EpiMLAkv{knb, vtb}, smem);
          } else if (kind == 2) hg_prefix_phase(local, dec);
          else did = false;
          break;
        case 3:
          if (kind == 1) mla_attn_phase(qb, knb, kpe, vtb, obf, ropet, smem);
          else if (kind == 2) hg_out_phase(z, vtb, lbv, local, p.in[12], obf, smem);
          else did = false;
          break;
        case 4: {
          const bf16* wo = (kind == 0) ? (na_out_t + (size_t)j * 1024 * 1024) : (kind == 1) ? mla_out_t : hg_out_t;
          gemm_bt<8>(obf, 1024, wo, 1024, T_TOK, 1024, 1024, EpiF32{mix, 1024}, smem);
        } break;
        case 5:
          ln_phase(hin, mix, p.in[18] + layer * 1024, p.in[19] + layer * 1024, hA, hbf);
          break;
        case 6:
          gemm_bt<8>(hbf, 1024, peer_wq_t + (size_t)layer * 2048 * 1024, 1024, T_TOK, 2048, 1024, EpiBF16{pq, 2048}, smem);
          break;
        case 7:
#pragma unroll 1
          for (int c = 0; c < 2; ++c)
            gemm_bt<4>(pq + c * 128, 256, peer_keys + (size_t)(layer * 2 + c) * 128 * 128, 128, T_TOK * 8, 128, 128, EpiBF16{psb + c * 128, 256}, smem);
          break;
        case 8:
          peer_topk_phase(psb, eidx, gate);
          break;
        default: {
          float* hout = (layer == 3) ? p.out : hB;
          peer_gather_phase(hA, ub + (size_t)layer * 16384 * 1024, vb + (size_t)layer * 16384 * 1024, usc + layer * 16384, vsc + layer * 16384,
                            eidx, gate, p.in[20] + layer * 1024, p.in[21] + layer * 1024, hout, hbf, smem);
        } break;
      }
      if (did && !(layer == 3 && sub == 9)) xcd_barrier(xb);
    }
  }
}

extern "C" void kernel_launch(void* const* d_in, const int* in_sizes, int n_in, void* d_out, int out_size, void* d_ws,
                              size_t ws_size, hipStream_t stream) {
  static int grid_blocks = 0;
  if (!grid_blocks) {
    int dev = 0, cus = 0, per_cu = 0;
    hipGetDevice(&dev);
    hipDeviceGetAttribute(&cus, hipDeviceAttributeMultiprocessorCount, dev);
    hipOccupancyMaxActiveBlocksPerMultiprocessor(&per_cu, mega_kernel, 256, 0);
    if (per_cu < 1) per_cu = 1;
    if (per_cu > 2) per_cu = 2;
    grid_blocks = cus * per_cu;
  }
  Params p{};
  for (int i = 0; i < 22; ++i) p.in[i] = (const float*)d_in[i];
  p.out = (float*)d_out;
  p.ws = (char*)d_ws;
  hipMemsetAsync((char*)d_ws + OFF_BAR, 0, 16384, stream);
  void* args[] = {&p};
  hipError_t e = hipLaunchCooperativeKernel((void*)mega_kernel, dim3(grid_blocks), dim3(256), args, 0, stream);
  if (e != hipSuccess) fprintf(stderr, "cooperative launch failed: %s (grid %d)\n", hipGetErrorString(e), grid_blocks);
}
```

```cpp
#include <hip/hip_runtime.h>
#include <hip/hip_cooperative_groups.h>
#include <stdint.h>
#include <cstdio>
namespace cg = cooperative_groups;

typedef unsigned short bf16;
using bf16x8 = __attribute__((ext_vector_type(8))) short;
using f32x4 = __attribute__((ext_vector_type(4))) float;

#define T_TOK 16384
#define SEQ 4096
#define DN_ALPHA 1.681792830507429f
#define NORM_EPS 1e-5f

constexpr size_t al256(size_t x) { return (x + 255) & ~(size_t)255; }
constexpr size_t SZ_NA_IN_T = (size_t)2 * 3072 * 1024 * 2;
constexpr size_t SZ_NA_OUT_T = (size_t)2 * 1024 * 1024 * 2;
constexpr size_t SZ_MLA_IN_T = (size_t)640 * 1024 * 2;
constexpr size_t SZ_MLA_QUP_T = (size_t)1536 * 256 * 2;
constexpr size_t SZ_MLA_KVUP_T = (size_t)2048 * 256 * 2;
constexpr size_t SZ_MLA_OUT_T = (size_t)1024 * 1024 * 2;
constexpr size_t SZ_HG_IN_T = (size_t)5120 * 1024 * 2;
constexpr size_t SZ_HG_OUT_T = (size_t)1024 * 1024 * 2;
constexpr size_t SZ_PEER_WQ_T = (size_t)4 * 2048 * 1024 * 2;
constexpr size_t SZ_PEER_KEYS = (size_t)4 * 2 * 128 * 128 * 2;
constexpr size_t SZ_UB = (size_t)4 * 16384 * 1024;
constexpr size_t SZ_USC = (size_t)4 * 16384 * 4;
constexpr size_t SZ_HF32 = (size_t)T_TOK * 1024 * 4;
constexpr size_t SZ_HBF = (size_t)T_TOK * 1024 * 2;
constexpr size_t SZ_R1 = (size_t)T_TOK * 5120 * 2;
constexpr size_t SZ_R2 = (size_t)T_TOK * 8 * 256 * 4;
constexpr size_t SZ_EIDX = (size_t)T_TOK * 128 * 4;
constexpr size_t SZ_DEC = (size_t)2048 * 2 * 128 * 4;
constexpr size_t SZ_LB = (size_t)2 * 1024 * 4;

constexpr size_t OFF_NA_IN_T = 0;
constexpr size_t OFF_NA_OUT_T = OFF_NA_IN_T + al256(SZ_NA_IN_T);
constexpr size_t OFF_MLA_IN_T = OFF_NA_OUT_T + al256(SZ_NA_OUT_T);
constexpr size_t OFF_MLA_QUP_T = OFF_MLA_IN_T + al256(SZ_MLA_IN_T);
constexpr size_t OFF_MLA_KVUP_T = OFF_MLA_QUP_T + al256(SZ_MLA_QUP_T);
constexpr size_t OFF_MLA_OUT_T = OFF_MLA_KVUP_T + al256(SZ_MLA_KVUP_T);
constexpr size_t OFF_HG_IN_T = OFF_MLA_OUT_T + al256(SZ_MLA_OUT_T);
constexpr size_t OFF_HG_OUT_T = OFF_HG_IN_T + al256(SZ_HG_IN_T);
constexpr size_t OFF_PEER_WQ_T = OFF_HG_OUT_T + al256(SZ_HG_OUT_T);
constexpr size_t OFF_PEER_KEYS = OFF_PEER_WQ_T + al256(SZ_PEER_WQ_T);
constexpr size_t OFF_UB = OFF_PEER_KEYS + al256(SZ_PEER_KEYS);
constexpr size_t OFF_VB = OFF_UB + al256(SZ_UB);
constexpr size_t OFF_HA = OFF_VB + al256(SZ_UB);
constexpr size_t OFF_HB = OFF_HA + al256(SZ_HF32);
constexpr size_t OFF_HBF = OFF_HB + al256(SZ_HF32);
constexpr size_t OFF_MIX = OFF_HBF + al256(SZ_HBF);
constexpr size_t OFF_R1 = OFF_MIX + al256(SZ_HF32);
constexpr size_t OFF_R2 = OFF_R1 + al256(SZ_R1);
constexpr size_t OFF_OBF = OFF_R2 + al256(SZ_R2);
constexpr size_t OFF_EIDX = OFF_OBF + al256(SZ_HBF);
constexpr size_t OFF_GATE = OFF_EIDX + al256(SZ_EIDX);
constexpr size_t OFF_VT = OFF_GATE + al256(SZ_EIDX);
constexpr size_t OFF_DEC = OFF_VT + al256(SZ_HBF);
constexpr size_t OFF_LB = OFF_DEC + al256(SZ_DEC);
constexpr size_t OFF_ROPE = OFF_LB + al256(SZ_LB);
constexpr size_t OFF_USC = OFF_ROPE + (size_t)2 * 4096 * 16 * 4;
constexpr size_t OFF_VSC = OFF_USC + al256(SZ_USC);
constexpr size_t OFF_BAR = OFF_VSC + al256(SZ_USC);
constexpr size_t WS_TOTAL = OFF_BAR + 16384;
static_assert(WS_TOTAL < ((size_t)1 << 30), "workspace must stay under 1 GiB");

struct Params {
  const float* in[22];
  float* out;
  char* ws;
};

typedef __bf16 hwbf2 __attribute__((ext_vector_type(2)));
typedef float hwf2 __attribute__((ext_vector_type(2)));
__device__ __forceinline__ unsigned pack2(float a, float b) {
  hwf2 v = {a, b};
  hwbf2 r = __builtin_convertvector(v, hwbf2);
  return __builtin_bit_cast(unsigned, r);
}
__device__ __forceinline__ bf16 f2bf(float f) { return (bf16)(pack2(f, 0.f) & 0xffffu); }
__device__ __forceinline__ float bf2f(bf16 h) { return __uint_as_float(((unsigned)h) << 16); }
__device__ __forceinline__ float bflo(unsigned w) { return __uint_as_float(w << 16); }
__device__ __forceinline__ float bfhi(unsigned w) { return __uint_as_float(w & 0xffff0000u); }
__device__ __forceinline__ int opaque_tid() {
  int t = threadIdx.x;
  asm volatile("" : "+v"(t));
  return t;
}
__device__ __forceinline__ int opaque_bid() {
  int b = blockIdx.x;
  asm volatile("" : "+s"(b));
  return b;
}
__device__ __forceinline__ float red_max_x32(float v) { const auto r = __builtin_amdgcn_permlane32_swap(__float_as_uint(v), __float_as_uint(v), false, false); return fmaxf(__uint_as_float(r[0]), __uint_as_float(r[1])); }
__device__ __forceinline__ float red_max_x16(float v) { const auto r = __builtin_amdgcn_permlane16_swap(__float_as_uint(v), __float_as_uint(v), false, false); return fmaxf(__uint_as_float(r[0]), __uint_as_float(r[1])); }
__device__ __forceinline__ float red_sum_x32(float v) { const auto r = __builtin_amdgcn_permlane32_swap(__float_as_uint(v), __float_as_uint(v), false, false); return __uint_as_float(r[0]) + __uint_as_float(r[1]); }
__device__ __forceinline__ float red_sum_x16(float v) { const auto r = __builtin_amdgcn_permlane16_swap(__float_as_uint(v), __float_as_uint(v), false, false); return __uint_as_float(r[0]) + __uint_as_float(r[1]); }
__device__ __forceinline__ float wave_sum(float v) {
  v = red_sum_x32(v);
  v = red_sum_x16(v);
  v += __int_as_float(__builtin_amdgcn_update_dpp(0, __float_as_int(v), 0x128, 0xF, 0xF, true));
  v += __int_as_float(__builtin_amdgcn_update_dpp(0, __float_as_int(v), 0xB1, 0xF, 0xF, true));
  v += __int_as_float(__builtin_amdgcn_update_dpp(0, __float_as_int(v), 0x4E, 0xF, 0xF, true));
  v += __int_as_float(__builtin_amdgcn_update_dpp(0, __float_as_int(v), 0x141, 0xF, 0xF, true));
  return v;
}
__device__ __forceinline__ float sigmoidf_(float x) { return __builtin_amdgcn_rcpf(1.0f + __expf(-x)); }
__device__ __forceinline__ f32x4 mfma16(bf16x8 a, bf16x8 b, f32x4 c) {
  return __builtin_amdgcn_mfma_f32_16x16x32_bf16(a, b, c, 0, 0, 0);
}
union U4B8 { uint4 u; bf16x8 v; };
__device__ __forceinline__ bf16x8 ld_frag16(const bf16* p) { U4B8 t; t.u = *(const uint4*)p; return t.v; }
__device__ __forceinline__ bf16x8 ld_frag8x2(const bf16* p0, const bf16* p1) {
  uint2 a = *(const uint2*)p0, b = *(const uint2*)p1;
  U4B8 t; t.u = make_uint4(a.x, a.y, b.x, b.y); return t.v;
}

__device__ void transpose_cvt(const float* __restrict__ src, bf16* __restrict__ dst, int K, int N, int Npad, char* smem) {
  float* tile = (float*)smem;
  const int tid = opaque_tid();
  const int bid_ = opaque_bid();
  const int tn_cnt = Npad >> 6, tk_cnt = K >> 6;
  const int ntiles = tn_cnt * tk_cnt;
  for (int t = bid_; t < ntiles; t += gridDim.x) {
    const int tk = t / tn_cnt, tn = t % tn_cnt;
    {
      const int j = tid & 63, i0 = tid >> 6;
      const int n = tn * 64 + j;
#pragma unroll 4
      for (int i = i0; i < 64; i += 4) {
        float v = (n < N) ? __builtin_nontemporal_load(src + (size_t)(tk * 64 + i) * N + n) : 0.0f;
        tile[i * 65 + j] = v;
      }
    }
    __syncthreads();
    {
      const int kk = tid & 63, n0 = tid >> 6;
#pragma unroll 4
      for (int nn = n0; nn < 64; nn += 4) {
        dst[(size_t)(tn * 64 + nn) * K + tk * 64 + kk] = f2bf(tile[kk * 65 + nn]);
      }
    }
    __syncthreads();
  }
}

__device__ void cvt_bf16(const float* __restrict__ src, bf16* __restrict__ dst, size_t n) {
  const size_t n8 = n >> 3;
  const size_t stride = (size_t)gridDim.x * 256;
  for (size_t i = (size_t)opaque_bid() * 256 + opaque_tid(); i < n8; i += stride) {
    float4 a = ((const float4*)src)[2 * i], b = ((const float4*)src)[2 * i + 1];
    uint4 o = make_uint4(pack2(a.x, a.y), pack2(a.z, a.w), pack2(b.x, b.y), pack2(b.z, b.w));
    ((uint4*)dst)[i] = o;
  }
}


__device__ void cvt_fp8_rows(const float* __restrict__ src, unsigned char* __restrict__ dst, float* __restrict__ isc, int nrows) {
  const int tid = opaque_tid();
  const int bid_ = opaque_bid();
  const int lane = tid & 63;
  const int gw = bid_ * 4 + (tid >> 6), nw = gridDim.x * 4;
  for (int row0 = gw * 2; row0 < nrows; row0 += nw * 2) {
    float4 v[2][4];
#pragma unroll
    for (int r = 0; r < 2; ++r)
#pragma unroll
      for (int c = 0; c < 4; ++c) {
        typedef float f4v_t __attribute__((ext_vector_type(4)));
        const f4v_t t_ = __builtin_nontemporal_load((const f4v_t*)(src + (size_t)(row0 + r) * 1024 + c * 256 + lane * 4));
        v[r][c] = make_float4(t_.x, t_.y, t_.z, t_.w);
      }
#pragma unroll
    for (int r = 0; r < 2; ++r) {
      float m = 0.f;
#pragma unroll
      for (int c = 0; c < 4; ++c) m = fmaxf(m, fmaxf(fmaxf(fabsf(v[r][c].x), fabsf(v[r][c].y)), fmaxf(fabsf(v[r][c].z), fabsf(v[r][c].w))));
#pragma unroll
      for (int o = 32; o >= 1; o >>= 1) m = fmaxf(m, __shfl_xor(m, o));
      const float sc = (m > 0.f) ? exp2f(floorf(log2f(240.0f / m))) : 1.0f;
#pragma unroll
      for (int c = 0; c < 4; ++c) {
        int wv = 0;
        wv = __builtin_amdgcn_cvt_pk_fp8_f32(v[r][c].x * sc, v[r][c].y * sc, wv, false);
        wv = __builtin_amdgcn_cvt_pk_fp8_f32(v[r][c].z * sc, v[r][c].w * sc, wv, true);
        int* dp_ = (int*)(dst + (size_t)(row0 + r) * 1024 + c * 256 + lane * 4);
        if (row0 >= 16384) __builtin_nontemporal_store(wv, dp_);
        else *dp_ = wv;
      }
      if (lane == 0) isc[row0 + r] = 1.0f / sc;
    }
  }
}

struct EpiF32 {
  float* C; int ldc;
  __device__ __forceinline__ void operator()(int row, int col, f32x4 v) const {
#pragma unroll
    for (int j = 0; j < 4; ++j) C[(size_t)(row + j) * ldc + col] = v[j];
  }
};
struct EpiBF16 {
  bf16* C; int ldc;
  __device__ __forceinline__ void operator()(int row, int col, f32x4 v) const {
#pragma unroll
    for (int j = 0; j < 4; ++j) C[(size_t)(row + j) * ldc + col] = f2bf(v[j]);
  }
};
struct EpiNAqkv {
  bf16* qk; bf16* vt;
  __device__ __forceinline__ void operator()(int row, int col, f32x4 v) const {
    if (col < 2048) {
#pragma unroll
      for (int j = 0; j < 4; ++j) qk[(size_t)(row + j) * 2048 + col] = f2bf(v[j]);
    } else {
      const int c = col - 2048, head = c >> 6, d = c & 63, b = row >> 12, s = row & 4095;
      uint2 o = make_uint2(pack2(v[0], v[1]), pack2(v[2], v[3]));
      *(uint2*)(vt + ((size_t)((b * 16 + head) * 64 + d)) * SEQ + s) = o;
    }
  }
};
struct EpiMLAkv {
  bf16* kn; bf16* vt;
  __device__ __forceinline__ void operator()(int row, int col, f32x4 v) const {
    const int head = col >> 7, wi = col & 127, b = row >> 12, s = row & 4095;
    if (wi < 64) {
#pragma unroll
      for (int j = 0; j < 4; ++j) kn[((size_t)((b * 16 + head) * SEQ + s + j)) * 64 + wi] = f2bf(v[j]);
    } else {
      uint2 o = make_uint2(pack2(v[0], v[1]), pack2(v[2], v[3]));
      *(uint2*)(vt + ((size_t)((b * 16 + head) * 64 + (wi - 64))) * SEQ + s) = o;
    }
  }
};
struct EpiHGin {
  bf16* z; bf16* vt;
  __device__ __forceinline__ void operator()(int row, int col, f32x4 v) const {
#pragma unroll
    for (int j = 0; j < 4; ++j) z[(size_t)(row + j) * 5120 + col] = f2bf(v[j]);
    if (col >= 3072 && col < 4096) {
      const int c = col - 3072, head = c >> 7, vv = c & 127, b = row >> 12, s = row & 4095;
      uint2 o = make_uint2(pack2(v[0], v[1]), pack2(v[2], v[3]));
      *(uint2*)(vt + ((size_t)((b * 8 + head) * 128 + vv)) * SEQ + s) = o;
    }
  }
};

#define GEMM_LDS_STRIDE 40
template <int NT, class Epi>
__device__ __forceinline__ void gemm_bt(const bf16* __restrict__ A, int lda, const bf16* __restrict__ Bt, int ldb,
                                        int M, int N, int K, const Epi& epi, char* smem) {
  constexpr int BN = 32 * NT;
  constexpr int NB = BN / 64;
  const int tid = opaque_tid(), lane = tid & 63, w = tid >> 6;
  const int bid_ = opaque_bid();
  const int wm = w >> 1, wn = w & 1;
  const int g = lane >> 4, r16 = lane & 15;
  bf16* sA = (bf16*)smem;
  bf16* sB = sA + 2 * 128 * GEMM_LDS_STRIDE;
  const int tilesN = N / BN;
  const int ntiles = (M >> 7) * tilesN;
  const int nk = K >> 5;
  const int lrow = tid >> 2, lkc = (tid & 3) * 8;
  const bool xsw = ((gridDim.x & 7) == 0) && (((M >> 7) & 7) == 0);
  const int t_first = xsw ? (bid_ >> 3) : bid_;
  const int t_step = xsw ? (int)(gridDim.x >> 3) : (int)gridDim.x;
  const int t_cnt = xsw ? (ntiles >> 3) : ntiles;
  for (int tq = t_first; tq < t_cnt; tq += t_step) {
    const int rbq = tq / tilesN;
    const int m0 = (xsw ? (rbq * 8 + (bid_ & 7)) : rbq) << 7, n0 = (tq % tilesN) * BN;
    f32x4 acc[4][NT];
#pragma unroll
    for (int i = 0; i < 4; ++i)
#pragma unroll
      for (int j = 0; j < NT; ++j) acc[i][j] = (f32x4){0.f, 0.f, 0.f, 0.f};
    const bf16* gA = A + (size_t)(m0 + lrow) * lda + lkc;
    const bf16* gB = Bt + (size_t)(n0 + lrow) * ldb + lkc;
    uint4 ra0, ra1, rb0, rb1, rb2, rb3;
#define GEMM_GLOAD(KO) do { \
      ra0 = *(const uint4*)(gA + (KO)); ra1 = *(const uint4*)(gA + (size_t)64 * lda + (KO)); \
      rb0 = *(const uint4*)(gB + (KO)); rb1 = *(const uint4*)(gB + (size_t)64 * ldb + (KO)); \
      if constexpr (NB == 4) { rb2 = *(const uint4*)(gB + (size_t)128 * ldb + (KO)); rb3 = *(const uint4*)(gB + (size_t)192 * ldb + (KO)); } } while (0)
#define GEMM_LSTORE(BUF) do { \
      bf16* dA_ = sA + (BUF) * 128 * GEMM_LDS_STRIDE + lrow * GEMM_LDS_STRIDE + lkc; \
      bf16* dB_ = sB + (BUF) * BN * GEMM_LDS_STRIDE + lrow * GEMM_LDS_STRIDE + lkc; \
      *(uint4*)dA_ = ra0; *(uint4*)(dA_ + 64 * GEMM_LDS_STRIDE) = ra1; \
      *(uint4*)dB_ = rb0; *(uint4*)(dB_ + 64 * GEMM_LDS_STRIDE) = rb1; \
      if constexpr (NB == 4) { *(uint4*)(dB_ + 128 * GEMM_LDS_STRIDE) = rb2; *(uint4*)(dB_ + 192 * GEMM_LDS_STRIDE) = rb3; } } while (0)
    GEMM_GLOAD(0);
    GEMM_LSTORE(0);
    __syncthreads();
    for (int kt = 0; kt < nk; ++kt) {
      const int cur = kt & 1;
      if (kt + 1 < nk) GEMM_GLOAD((kt + 1) * 32);
      const bf16* a_base = sA + cur * 128 * GEMM_LDS_STRIDE + (wm * 64 + r16) * GEMM_LDS_STRIDE + g * 8;
      const bf16* b_base = sB + cur * BN * GEMM_LDS_STRIDE + (wn * (16 * NT) + r16) * GEMM_LDS_STRIDE + g * 8;
      bf16x8 af[4];
#pragma unroll
      for (int i = 0; i < 4; ++i) af[i] = ld_frag16(a_base + i * 16 * GEMM_LDS_STRIDE);
#pragma unroll
      for (int jh = 0; jh < NT / 4; ++jh) {
        bf16x8 bfr[4];
#pragma unroll
        for (int j = 0; j < 4; ++j) bfr[j] = ld_frag16(b_base + (jh * 4 + j) * 16 * GEMM_LDS_STRIDE);
        __builtin_amdgcn_s_setprio(1);
#pragma unroll
        for (int i = 0; i < 4; ++i)
#pragma unroll
          for (int j = 0; j < 4; ++j) acc[i][jh * 4 + j] = mfma16(af[i], bfr[j], acc[i][jh * 4 + j]);
        __builtin_amdgcn_s_setprio(0);
      }
      if (kt + 1 < nk) GEMM_LSTORE(cur ^ 1);
      __syncthreads();
    }
#pragma unroll
    for (int i = 0; i < 4; ++i)
#pragma unroll
      for (int j = 0; j < NT; ++j) epi(m0 + wm * 64 + i * 16 + g * 4, n0 + wn * (16 * NT) + j * 16 + r16, acc[i][j]);
  }
}

__device__ void ln_phase(const float* __restrict__ hin, const float* __restrict__ mix, const float* __restrict__ gam,
                         const float* __restrict__ bet, float* __restrict__ hout, bf16* __restrict__ hbf) {
  const int tid = opaque_tid();
  const int bid_ = opaque_bid();
  const int lane = tid & 63;
  const int gw = bid_ * 4 + (tid >> 6), nw = gridDim.x * 4;
  for (int row = gw; row < T_TOK; row += nw) {
    float v[16];
    float s = 0.f;
#pragma unroll
    for (int c = 0; c < 4; ++c) {
      const size_t o = (size_t)row * 1024 + c * 256 + lane * 4;
      typedef float f4v_t __attribute__((ext_vector_type(4)));
      const f4v_t a_ = __builtin_nontemporal_load((const f4v_t*)(hin + o)), m_ = __builtin_nontemporal_load((const f4v_t*)(mix + o));
      const float4 a = make_float4(a_.x, a_.y, a_.z, a_.w), m = make_float4(m_.x, m_.y, m_.z, m_.w);
      v[c * 4 + 0] = DN_ALPHA * a.x + m.x; v[c * 4 + 1] = DN_ALPHA * a.y + m.y;
      v[c * 4 + 2] = DN_ALPHA * a.z + m.z; v[c * 4 + 3] = DN_ALPHA * a.w + m.w;
      s += v[c * 4 + 0] + v[c * 4 + 1] + v[c * 4 + 2] + v[c * 4 + 3];
    }
    const float mu = wave_sum(s) * (1.0f / 1024.0f);
    float q = 0.f;
#pragma unroll
    for (int i = 0; i < 16; ++i) { float d = v[i] - mu; q += d * d; }
    const float rstd = rsqrtf(wave_sum(q) * (1.0f / 1024.0f) + NORM_EPS);
#pragma unroll
    for (int c = 0; c < 4; ++c) {
      const int col = c * 256 + lane * 4;
      float4 gg = *(const float4*)(gam + col), bb = *(const float4*)(bet + col);
      float4 o;
      o.x = (v[c * 4 + 0] - mu) * rstd * gg.x + bb.x; o.y = (v[c * 4 + 1] - mu) * rstd * gg.y + bb.y;
      o.z = (v[c * 4 + 2] - mu) * rstd * gg.z + bb.z; o.w = (v[c * 4 + 3] - mu) * rstd * gg.w + bb.w;
      *(float4*)(hout + (size_t)row * 1024 + col) = o;
      *(uint2*)(hbf + (size_t)row * 1024 + col) = make_uint2(pack2(o.x, o.y), pack2(o.z, o.w));
    }
  }
}

__device__ void na_attn_phase(const bf16* __restrict__ qk, const bf16* __restrict__ vt, const float* __restrict__ rel_bias,
                              bf16* __restrict__ o, char* smem) {
  const int tid = opaque_tid();
  const int bid_ = opaque_bid();
  const int lane = tid & 63, w = tid >> 6, g = lane >> 4, r16 = lane & 15;
  const int s0 = (w == 0) ? 0 : (w == 1) ? 8 : (w == 2) ? 24 : 32;
  const int wq = 16 * w + r16;
  const int c0 = min(max(wq - 8, 0), 48);
  const bool xsw = (gridDim.x & 7) == 0;
  const int i_first = xsw ? (bid_ >> 3) : bid_;
  const int i_step = xsw ? (int)(gridDim.x >> 3) : (int)gridDim.x;
  const int i_cnt = xsw ? 512 : 4096;
  for (int iq = i_first; iq < i_cnt; iq += i_step) {
    const int item = xsw ? (((((iq >> 6) << 3) + (bid_ & 7)) << 6) + (iq & 63)) : iq;
    const int pair_ = xsw ? (item >> 6) : (((item >> 10) << 4) | (item & 15));
    const int head = pair_ & 15, r = xsw ? (item & 63) : ((item >> 4) & 63), b = pair_ >> 4;
    const int r0 = min(max(r - 4, 0), 56);
    float* sb = (float*)smem;
    __syncthreads();
    for (int i = tid; i < 480; i += 256) {
      const int rr = i >> 5, cc = i & 31;
      sb[i] = (cc < 31) ? rel_bias[(head * 15 + rr) * 31 + cc] * 1.4426950408889634f : 0.f;
    }
    __syncthreads();
    const int tq = b * SEQ + r * 64 + wq;
    bf16x8 qf[2];
#pragma unroll
    for (int ks = 0; ks < 2; ++ks) qf[ks] = ld_frag16(qk + (size_t)tq * 2048 + head * 64 + ks * 32 + g * 8);
    f32x4 st[8][2];
#pragma unroll
    for (int kr2 = 0; kr2 < 4; ++kr2) {
      bf16x8 ka[8];
#pragma unroll
      for (int q = 0; q < 8; ++q) {
        const int kr = kr2 * 2 + (q >> 2), kt = (q >> 1) & 1, ks = q & 1;
        const int tk = b * SEQ + (r0 + kr) * 64 + s0 + 8 * (r16 >> 2) + 4 * kt + (r16 & 3);
        ka[q] = ld_frag16(qk + (size_t)tk * 2048 + 1024 + head * 64 + ks * 32 + g * 8);
      }
      __builtin_amdgcn_sched_barrier(0);
#pragma unroll
      for (int q = 0; q < 8; q += 2) {
        const int kr = kr2 * 2 + (q >> 2), kt = (q >> 1) & 1;
        f32x4 acc = (f32x4){0.f, 0.f, 0.f, 0.f};
        acc = mfma16(ka[q], qf[0], acc);
        acc = mfma16(ka[q + 1], qf[1], acc);
        st[kr][kt] = acc;
      }
      __builtin_amdgcn_sched_barrier(0);
    }
    float mx = -INFINITY;
#pragma unroll
    for (int kr = 0; kr < 8; ++kr)
#pragma unroll
      for (int kt = 0; kt < 2; ++kt)
#pragma unroll
        for (int jj = 0; jj < 4; ++jj) {
          const int kc = s0 + 8 * g + 4 * kt + jj;
          const bool valid = (kc >= c0) && (kc < c0 + 16);
          const int dr = r0 + kr - r + 7;
          const int dc = min(max(kc - wq + 15, 0), 30);
          float bias = sb[dr * 32 + dc];
          asm volatile("" : "+v"(bias));
          const float val = valid ? fmaf(st[kr][kt][jj], 0.125f * 1.4426950408889634f, bias) : -INFINITY;
          st[kr][kt][jj] = val;
          mx = fmaxf(mx, val);
        }
    mx = red_max_x16(mx);
    mx = red_max_x32(mx);
    float sum = 0.f;
#pragma unroll
    for (int kr = 0; kr < 8; ++kr)
#pragma unroll
      for (int kt = 0; kt < 2; ++kt)
#pragma unroll
        for (int jj = 0; jj < 4; ++jj) {
          const float pv = __builtin_amdgcn_exp2f(st[kr][kt][jj] - mx);
          st[kr][kt][jj] = pv;
          sum += pv;
        }
    sum = red_sum_x16(sum);
    sum = red_sum_x32(sum);
    f32x4 oacc[4];
#pragma unroll
    for (int dt = 0; dt < 4; ++dt) oacc[dt] = (f32x4){0.f, 0.f, 0.f, 0.f};
#pragma unroll
    for (int kr2 = 0; kr2 < 4; ++kr2) {
      bf16x8 va[8];
#pragma unroll
      for (int q = 0; q < 8; ++q) {
        const int kr = kr2 * 2 + (q >> 2), dt = q & 3;
        va[q] = ld_frag16(vt + ((size_t)((b * 16 + head) * 64 + dt * 16 + r16)) * SEQ + (r0 + kr) * 64 + s0 + 8 * g);
      }
      __builtin_amdgcn_sched_barrier(0);
#pragma unroll
      for (int q = 0; q < 8; ++q) {
        const int kr = kr2 * 2 + (q >> 2), dt = q & 3;
        U4B8 pb;
        pb.u = make_uint4(pack2(st[kr][0][0], st[kr][0][1]), pack2(st[kr][0][2], st[kr][0][3]),
                          pack2(st[kr][1][0], st[kr][1][1]), pack2(st[kr][1][2], st[kr][1][3]));
        oacc[dt] = mfma16(va[q], pb.v, oacc[dt]);
      }
      __builtin_amdgcn_sched_barrier(0);
    }
    const float inv = 1.0f / sum;
#pragma unroll
    for (int dt = 0; dt < 4; ++dt) {
      uint2 ov = make_uint2(pack2(oacc[dt][0] * inv, oacc[dt][1] * inv), pack2(oacc[dt][2] * inv, oacc[dt][3] * inv));
      *(uint2*)(o + (size_t)tq * 1024 + head * 64 + dt * 16 + 4 * g) = ov;
    }
  }
}

__device__ void mla_prep_phase(const float* __restrict__ hin  , const float* __restrict__ rope, const float* __restrict__ qn, const float* __restrict__ kvn,
                               bf16* __restrict__ cqn, bf16* __restrict__ ckvn, bf16* __restrict__ kpe) {
  const int tid = opaque_tid();
  const int bid_ = opaque_bid();
  const int lane = tid & 63;
  const int gw = bid_ * 4 + (tid >> 6), nw = gridDim.x * 4;
  for (int t = gw; t < T_TOK; t += nw) {
    const float* row = hin + (size_t)t * 640;
    float4 a = *(const float4*)(row + lane * 4);
    float4 c = *(const float4*)(row + 256 + lane * 4);
    float sa = wave_sum(a.x * a.x + a.y * a.y + a.z * a.z + a.w * a.w);
    float sc = wave_sum(c.x * c.x + c.y * c.y + c.z * c.z + c.w * c.w);
    const float ra = rsqrtf(sa * (1.0f / 256.0f) + NORM_EPS), rc = rsqrtf(sc * (1.0f / 256.0f) + NORM_EPS);
    float4 ga = *(const float4*)(qn + lane * 4), gc = *(const float4*)(kvn + lane * 4);
    *(uint2*)(cqn + (size_t)t * 256 + lane * 4) = make_uint2(pack2(a.x * ra * ga.x, a.y * ra * ga.y), pack2(a.z * ra * ga.z, a.w * ra * ga.w));
    *(uint2*)(ckvn + (size_t)t * 256 + lane * 4) = make_uint2(pack2(c.x * rc * gc.x, c.y * rc * gc.y), pack2(c.z * rc * gc.z, c.w * rc * gc.w));
    if (lane < 16) {
      const float x1 = row[512 + lane], x2 = row[528 + lane];
      const float cs = rope[(t & 4095) * 16 + lane], sn = rope[4096 * 16 + (t & 4095) * 16 + lane];
      kpe[(size_t)t * 32 + lane] = f2bf(x1 * cs - x2 * sn);
      kpe[(size_t)t * 32 + 16 + lane] = f2bf(x1 * sn + x2 * cs);
    }
  }
}

#define MLA_KS 104
#define MLA_VS 72
__device__ void mla_attn_phase(const bf16* __restrict__ q  , const bf16* __restrict__ kn  ,
                               const bf16* __restrict__ kpe  , const bf16* __restrict__ vt  ,
                               bf16* __restrict__ o  , const float* __restrict__ rope, char* smem) {
  const int tid = opaque_tid(), lane = tid & 63, w = tid >> 6, g = lane >> 4, r16 = lane & 15;
  const int bid_ = opaque_bid();
  bf16* sK = (bf16*)smem;
  bf16* sV = sK + 2 * 64 * MLA_KS;
  const float sc2 = 0.10206207261596575f * 1.4426950408889634f;
  const bool xsw = (gridDim.x & 7) == 0;
  const int i_first = xsw ? (bid_ >> 3) : bid_;
  const int i_step = xsw ? (int)(gridDim.x >> 3) : (int)gridDim.x;
  const int i_cnt = xsw ? 256 : 2048;
  for (int iq = i_first; iq < i_cnt; iq += i_step) {
    const int item = xsw ? (((((iq >> 5) << 3) + (bid_ & 7)) << 5) + (iq & 31)) : iq;
    const int qb = item & 31, head = (item >> 5) & 15, b = item >> 9;
    const int bh = b * 16 + head;
    bf16x8 qf[2][3];
#pragma unroll
    for (int qt = 0; qt < 2; ++qt) {
      const int tq = b * SEQ + qb * 128 + w * 32 + qt * 16 + r16;
      const bf16* qrow = q + (size_t)tq * 1536 + head * 96;
      qf[qt][0] = ld_frag16(qrow + g * 8);
      qf[qt][1] = ld_frag16(qrow + 32 + g * 8);
      const int i0 = 8 * (g & 1);
      uint4 x1r = *(const uint4*)(qrow + 64 + i0), x2r = *(const uint4*)(qrow + 80 + i0);
      const unsigned x1w[4] = {x1r.x, x1r.y, x1r.z, x1r.w}, x2w[4] = {x2r.x, x2r.y, x2r.z, x2r.w};
      float res[8];
      const float* cp = rope + (tq & 4095) * 16 + i0;
      const float4 c0 = *(const float4*)cp, c1 = *(const float4*)(cp + 4);
      const float4 s0 = *(const float4*)(cp + 4096 * 16), s1 = *(const float4*)(cp + 4096 * 16 + 4);
      const float csv[8] = {c0.x, c0.y, c0.z, c0.w, c1.x, c1.y, c1.z, c1.w};
      const float snv[8] = {s0.x, s0.y, s0.z, s0.w, s1.x, s1.y, s1.z, s1.w};
#pragma unroll
      for (int j = 0; j < 8; ++j) {
        const float x1 = (j & 1) ? bfhi(x1w[j >> 1]) : bflo(x1w[j >> 1]);
        const float x2 = (j & 1) ? bfhi(x2w[j >> 1]) : bflo(x2w[j >> 1]);
        res[j] = (g < 2) ? (x1 * csv[j] - x2 * snv[j]) : (x1 * snv[j] + x2 * csv[j]);
      }
      U4B8 t; t.u = make_uint4(pack2(res[0], res[1]), pack2(res[2], res[3]), pack2(res[4], res[5]), pack2(res[6], res[7]));
      qf[qt][2] = t.v;
    }
    uint4 rk0, rk1, rk2, rv0, rv1;
    const bf16* kn_b = kn + (size_t)bh * SEQ * 64;
    const bf16* kpe_b = kpe + (size_t)b * SEQ * 32;
    const bf16* vt_b = vt + (size_t)bh * 64 * SEQ;
    const unsigned ko = (unsigned)tid * 8u;
    const unsigned vo0 = (unsigned)(tid >> 3) * SEQ + (unsigned)(tid & 7) * 8u;
    const unsigned vo1 = vo0 + 32u * SEQ;
    auto gload = [&](int kt) {
      const bf16* kb = kn_b + (size_t)kt * 64 * 64;
      const bf16* pb_ = kpe_b + (size_t)kt * 64 * 32;
      const bf16* vb_ = vt_b + (size_t)kt * 64;
      asm volatile("" : "+s"(kb), "+s"(pb_), "+s"(vb_));
      typedef unsigned v4u_t __attribute__((ext_vector_type(4)));
      typedef const v4u_t __attribute__((address_space(1))) * gp_t;
      const v4u_t t0 = *(gp_t)(kb + ko), t1 = *(gp_t)(kb + ko + 2048u), t2 = *(gp_t)(pb_ + ko), t3 = *(gp_t)(vb_ + vo0), t4 = *(gp_t)(vb_ + vo1);
      rk0 = make_uint4(t0.x, t0.y, t0.z, t0.w); rk1 = make_uint4(t1.x, t1.y, t1.z, t1.w); rk2 = make_uint4(t2.x, t2.y, t2.z, t2.w);
      rv0 = make_uint4(t3.x, t3.y, t3.z, t3.w); rv1 = make_uint4(t4.x, t4.y, t4.z, t4.w);
    };
    auto lstore = [&](int buf) {
      bf16* dk = sK + buf * 64 * MLA_KS;
      *(uint4*)(dk + (tid >> 3) * MLA_KS + (tid & 7) * 8) = rk0;
      *(uint4*)(dk + (32 + (tid >> 3)) * MLA_KS + (tid & 7) * 8) = rk1;
      *(uint4*)(dk + (tid >> 2) * MLA_KS + 64 + (tid & 3) * 8) = rk2;
      bf16* dv = sV + buf * 64 * MLA_VS;
      *(uint4*)(dv + (tid >> 3) * MLA_VS + (tid & 7) * 8) = rv0;
      *(uint4*)(dv + (32 + (tid >> 3)) * MLA_VS + (tid & 7) * 8) = rv1;
    };
    gload(0);
    lstore(0);
    __syncthreads();
    float m_[2] = {-INFINITY, -INFINITY}, l_[2] = {0.f, 0.f};
    f32x4 oacc[2][4];
#pragma unroll
    for (int qt = 0; qt < 2; ++qt)
#pragma unroll
      for (int dt = 0; dt < 4; ++dt) oacc[qt][dt] = (f32x4){0.f, 0.f, 0.f, 0.f};
#pragma unroll 1
    for (int kt = 0; kt < 64; ++kt) {
      const int cur = kt & 1;
      if (kt + 1 < 64) gload(kt + 1);
      f32x4 s[2][4];
#pragma unroll
      for (int qt = 0; qt < 2; ++qt)
#pragma unroll
        for (int k4 = 0; k4 < 4; ++k4) s[qt][k4] = (f32x4){0.f, 0.f, 0.f, 0.f};
      __builtin_amdgcn_s_setprio(1);
#pragma unroll
      for (int k4 = 0; k4 < 4; ++k4)
#pragma unroll
        for (int ks = 0; ks < 3; ++ks) {
          bf16x8 a = ld_frag16(sK + cur * 64 * MLA_KS + (32 * (k4 >> 1) + 8 * (r16 >> 2) + 4 * (k4 & 1) + (r16 & 3)) * MLA_KS + ks * 32 + g * 8);
#pragma unroll
          for (int qt = 0; qt < 2; ++qt) s[qt][k4] = mfma16(a, qf[qt][ks], s[qt][k4]);
        }
      __builtin_amdgcn_s_setprio(0);
      bf16x8 pb[2][2];
#pragma unroll
      for (int qt = 0; qt < 2; ++qt) {
        float mx = -INFINITY;
#pragma unroll
        for (int k4 = 0; k4 < 4; ++k4)
#pragma unroll
          for (int jj = 0; jj < 4; ++jj) mx = fmaxf(mx, s[qt][k4][jj]);
        mx = red_max_x16(mx);
        mx = red_max_x32(mx);
        const float mxs = mx * sc2;
        if (__builtin_amdgcn_ballot_w64(mxs > m_[qt] + 11.541560327111707f) != 0ull) {
          const float mnew = fmaxf(m_[qt], mxs);
          const float alpha = __builtin_amdgcn_exp2f(m_[qt] - mnew);
          m_[qt] = mnew;
          l_[qt] *= alpha;
#pragma unroll
          for (int dt = 0; dt < 4; ++dt)
#pragma unroll
            for (int jj = 0; jj < 4; ++jj) oacc[qt][dt][jj] *= alpha;
        }
        const float mcur = m_[qt];
        float ps = 0.f;
#pragma unroll
        for (int k4 = 0; k4 < 4; ++k4)
#pragma unroll
          for (int jj = 0; jj < 4; ++jj) { const float pv = __builtin_amdgcn_exp2f(fmaf(s[qt][k4][jj], sc2, -mcur)); s[qt][k4][jj] = pv; ps += pv; }
        l_[qt] += ps;
#pragma unroll
        for (int kk = 0; kk < 2; ++kk) {
          U4B8 t;
          t.u = make_uint4(pack2(s[qt][2 * kk][0], s[qt][2 * kk][1]), pack2(s[qt][2 * kk][2], s[qt][2 * kk][3]),
                           pack2(s[qt][2 * kk + 1][0], s[qt][2 * kk + 1][1]), pack2(s[qt][2 * kk + 1][2], s[qt][2 * kk + 1][3]));
          pb[qt][kk] = t.v;
        }
      }
      __builtin_amdgcn_s_setprio(1);
#pragma unroll
      for (int dt = 0; dt < 4; ++dt)
#pragma unroll
        for (int kk = 0; kk < 2; ++kk) {
          const bf16* base = sV + cur * 64 * MLA_VS + (dt * 16 + r16) * MLA_VS + kk * 32 + 8 * g;
          bf16x8 a = ld_frag16(base);
#pragma unroll
          for (int qt = 0; qt < 2; ++qt) oacc[qt][dt] = mfma16(a, pb[qt][kk], oacc[qt][dt]);
        }
      __builtin_amdgcn_s_setprio(0);
      if (kt + 1 < 64) lstore(cur ^ 1);
      __syncthreads();
    }
#pragma unroll
    for (int qt = 0; qt < 2; ++qt) {
      float ls = l_[qt];
      ls = red_sum_x16(ls);
      ls = red_sum_x32(ls);
      const float inv = 1.0f / ls;
      const int tq = b * SEQ + qb * 128 + w * 32 + qt * 16 + r16;
#pragma unroll
      for (int dt = 0; dt < 4; ++dt) {
        uint2 ov = make_uint2(pack2(oacc[qt][dt][0] * inv, oacc[qt][dt][1] * inv), pack2(oacc[qt][dt][2] * inv, oacc[qt][dt][3] * inv));
        *(uint2*)(o + (size_t)tq * 1024 + head * 64 + dt * 16 + 4 * g) = ov;
      }
    }
  }
}

#define HG_KS 72
#define HG_QS 136
#define HG_AS 72
__device__ void hg_local_phase(const bf16* __restrict__ z, const bf16* __restrict__ vt, const float* __restrict__ lbv,
                               bf16* __restrict__ local, float* __restrict__ dec, char* smem) {
  const int tid = opaque_tid(), lane = tid & 63, w = tid >> 6, g = lane >> 4, r16 = lane & 15;
  const int bid_ = opaque_bid();
  bf16* sZ = (bf16*)smem;
  bf16* sKl = sZ + 64 * HG_QS;
  float* sTot = (float*)(sKl + 128 * HG_KS);
  for (int item = bid_; item < 2048; item += gridDim.x) {
    const int n = item & 63, hd = (item >> 6) & 7, b = item >> 9;
    const int tok0 = b * SEQ + n * 64;
#pragma unroll 1
    for (int dir = 0; dir < 2; ++dir) {
#pragma unroll
      for (int i = 0; i < 4; ++i) {
        const int c = tid + 256 * i, row = c >> 4, cc = c & 15;
        *(uint4*)(sZ + row * HG_QS + cc * 8) = *(const uint4*)(z + (size_t)(tok0 + row) * 5120 + (1 + dir) * 1024 + hd * 128 + cc * 8);
      }
      __syncthreads();
      {
        const int f = tid & 127, half = tid >> 7, hbase = half * 32;
        const int first = dir ? 0 : 1;
        const float lb = lbv[dir * 1024 + hd * 128 + f];
        float lfv[32];
        float tot = 0.f;
#pragma unroll
        for (int i = 0; i < 32; ++i) {
          const int t = dir ? (hbase + i) : (hbase + 31 - i);
          const float zf = bf2f(sZ[t * HG_QS + f]);
          const float sg = sigmoidf_(zf);
          lfv[i] = __logf(lb + (1.0f - lb) * sg);
          tot += lfv[i];
        }
        sTot[half * 128 + f] = tot;
        __syncthreads();
        float run = (half == first) ? 0.f : sTot[first * 128 + f];
#pragma unroll
        for (int i = 0; i < 32; ++i) {
          const int t = dir ? (hbase + i) : (hbase + 31 - i);
          sKl[f * HG_KS + t] = f2bf((1.0f - __expf(lfv[i])) * __expf(run));
          run += lfv[i];
        }
        if (half != first) dec[(size_t)(item * 2 + dir) * 128 + f] = __expf(run);
      }
      __syncthreads();
      f32x4 acc[2][8];
#pragma unroll
      for (int fi = 0; fi < 2; ++fi)
#pragma unroll
        for (int v8 = 0; v8 < 8; ++v8) acc[fi][v8] = (f32x4){0.f, 0.f, 0.f, 0.f};
#pragma unroll
      for (int kk = 0; kk < 2; ++kk) {
        bf16x8 a[2];
#pragma unroll
        for (int fi = 0; fi < 2; ++fi) a[fi] = ld_frag16(sKl + ((2 * w + fi) * 16 + r16) * HG_KS + kk * 32 + g * 8);
#pragma unroll
        for (int v8 = 0; v8 < 8; ++v8) {
          bf16x8 bb = ld_frag16(vt + ((size_t)((b * 8 + hd) * 128 + v8 * 16 + r16)) * SEQ + n * 64 + kk * 32 + g * 8);
#pragma unroll
          for (int fi = 0; fi < 2; ++fi) acc[fi][v8] = mfma16(a[fi], bb, acc[fi][v8]);
        }
      }
      bf16* lp = local + (size_t)(item * 2 + dir) * 16384;
#pragma unroll
      for (int fi = 0; fi < 2; ++fi)
#pragma unroll
        for (int v8 = 0; v8 < 8; ++v8) {
          uint2 o = make_uint2(pack2(acc[fi][v8][0], acc[fi][v8][1]), pack2(acc[fi][v8][2], acc[fi][v8][3]));
          *(uint2*)(lp + (v8 * 16 + r16) * 128 + (2 * w + fi) * 16 + 4 * g) = o;
        }
      __syncthreads();
    }
  }
}
__device__ void hg_prefix_phase(bf16* __restrict__ local, const float* __restrict__ dec) {
  const int total = 64 * 2048;
  for (int idx = opaque_bid() * 256 + opaque_tid(); idx < total; idx += gridDim.x * 256) {
    const int chain = idx >> 11, e8 = idx & 2047;
    const int bh = chain >> 1, dir = chain & 1;
    const int f0 = (e8 * 8) & 127;
    float r[8];
#pragma unroll
    for (int j = 0; j < 8; ++j) r[j] = 0.f;
#pragma unroll 8
    for (int i = 0; i < 64; ++i) {
      const int n = dir ? 63 - i : i;
      const size_t idn = (size_t)((bh * 64 + n) * 2 + dir);
      uint4* ptr = (uint4*)(local + idn * 16384 + (size_t)e8 * 8);
      const uint4 raw = *ptr;
      const float4 d0 = *(const float4*)(dec + idn * 128 + f0), d1 = *(const float4*)(dec + idn * 128 + f0 + 4);
      *ptr = make_uint4(pack2(r[0], r[1]), pack2(r[2], r[3]), pack2(r[4], r[5]), pack2(r[6], r[7]));
      r[0] = d0.x * r[0] + bflo(raw.x); r[1] = d0.y * r[1] + bfhi(raw.x);
      r[2] = d0.z * r[2] + bflo(raw.y); r[3] = d0.w * r[3] + bfhi(raw.y);
      r[4] = d1.x * r[4] + bflo(raw.z); r[5] = d1.y * r[5] + bfhi(raw.z);
      r[6] = d1.z * r[6] + bflo(raw.w); r[7] = d1.w * r[7] + bfhi(raw.w);
    }
  }
}
__device__ void hg_out_phase(const bf16* __restrict__ z, const bf16* __restrict__ vt, const float* __restrict__ lbv,
                             const bf16* __restrict__ state, const float* __restrict__ normg, bf16* __restrict__ og, char* smem) {
  const int tid = opaque_tid(), lane = tid & 63, w = tid >> 6, g = lane >> 4, r16 = lane & 15;
  const int bid_ = opaque_bid();
  bf16* sQ = (bf16*)smem;
  bf16* sKd = sQ + 64 * HG_QS;
  bf16* sAt = sKd + 64 * HG_QS;
  float* sTot = (float*)(sAt + 64 * HG_AS);
  for (int item = bid_; item < 2048; item += gridDim.x) {
    const int n = item & 63, hd = (item >> 6) & 7, b = item >> 9;
    const int tok0 = b * SEQ + n * 64;
    f32x4 oacc[8];
#pragma unroll
    for (int v8 = 0; v8 < 8; ++v8) oacc[v8] = (f32x4){0.f, 0.f, 0.f, 0.f};
#pragma unroll 1
    for (int dir = 0; dir < 2; ++dir) {
#pragma unroll
      for (int i = 0; i < 4; ++i) {
        const int c = tid + 256 * i, row = c >> 4, cc = c & 15;
        const bf16* zr = z + (size_t)(tok0 + row) * 5120 + hd * 128 + cc * 8;
        *(uint4*)(sQ + row * HG_QS + cc * 8) = *(const uint4*)zr;
        *(uint4*)(sKd + row * HG_QS + cc * 8) = *(const uint4*)(zr + (1 + dir) * 1024);
      }
      __syncthreads();
      {
        const int f = tid & 127, half = tid >> 7, hbase = half * 32;
        const int first = dir ? 1 : 0;
        const float lb = lbv[dir * 1024 + hd * 128 + f];
        float lfv[32];
        float tot = 0.f;
#pragma unroll
        for (int i = 0; i < 32; ++i) {
          const int t = dir ? (hbase + 31 - i) : (hbase + i);
          const float zf = bf2f(sKd[t * HG_QS + f]);
          const float sg = sigmoidf_(zf);
          lfv[i] = __logf(lb + (1.0f - lb) * sg);
          tot += lfv[i];
        }
        sTot[half * 128 + f] = tot;
        __syncthreads();
        float run = (half == first) ? 0.f : sTot[first * 128 + f];
#pragma unroll
        for (int i = 0; i < 32; ++i) {
          const int t = dir ? (hbase + 31 - i) : (hbase + i);
          run += lfv[i];
          const float zz = bf2f(sQ[t * HG_QS + f]);
          const float qv = zz * sigmoidf_(zz);
          sQ[t * HG_QS + f] = f2bf(qv * __expf(run));
          sKd[t * HG_QS + f] = f2bf((1.0f - __expf(lfv[i])) * __expf(-run));
        }
      }
      __syncthreads();
      {
        f32x4 a4[4];
#pragma unroll
        for (int st = 0; st < 4; ++st) a4[st] = (f32x4){0.f, 0.f, 0.f, 0.f};
#pragma unroll
        for (int kk = 0; kk < 4; ++kk) {
          bf16x8 a = ld_frag16(sQ + (16 * w + r16) * HG_QS + kk * 32 + g * 8);
#pragma unroll
          for (int st = 0; st < 4; ++st) {
            bf16x8 bb = ld_frag16(sKd + (16 * st + r16) * HG_QS + kk * 32 + g * 8);
            a4[st] = mfma16(a, bb, a4[st]);
          }
        }
#pragma unroll
        for (int st = 0; st < 4; ++st)
#pragma unroll
          for (int jj = 0; jj < 4; ++jj) {
            const int t = 16 * w + 4 * g + jj, s = 16 * st + r16;
            const bool keep = dir ? (s >= t) : (s <= t);
            sAt[t * HG_AS + s] = f2bf(keep ? a4[st][jj] : 0.f);
          }
      }
      __syncthreads();
#pragma unroll 1
      for (int kk = 0; kk < 2; ++kk) {
        bf16x8 a = ld_frag16(sAt + (16 * w + r16) * HG_AS + kk * 32 + g * 8);
        bf16x8 bb[8];
#pragma unroll
        for (int v8 = 0; v8 < 8; ++v8) bb[v8] = ld_frag16(vt + ((size_t)((b * 8 + hd) * 128 + v8 * 16 + r16)) * SEQ + n * 64 + kk * 32 + g * 8);
        __builtin_amdgcn_sched_barrier(0);
#pragma unroll
        for (int v8 = 0; v8 < 8; ++v8) oacc[v8] = mfma16(a, bb[v8], oacc[v8]);
        __builtin_amdgcn_sched_barrier(0);
      }
      const bf16* sp = state + (size_t)(item * 2 + dir) * 16384;
#pragma unroll 1
      for (int kk = 0; kk < 4; ++kk) {
        bf16x8 a = ld_frag16(sQ + (16 * w + r16) * HG_QS + kk * 32 + g * 8);
        bf16x8 bb[8];
#pragma unroll
        for (int v8 = 0; v8 < 8; ++v8) bb[v8] = ld_frag16(sp + (v8 * 16 + r16) * 128 + kk * 32 + g * 8);
        __builtin_amdgcn_sched_barrier(0);
#pragma unroll
        for (int v8 = 0; v8 < 8; ++v8) oacc[v8] = mfma16(a, bb[v8], oacc[v8]);
        __builtin_amdgcn_sched_barrier(0);
      }
      __syncthreads();
    }
    float rs[4];
#pragma unroll
    for (int jj = 0; jj < 4; ++jj) {
      float ss = 0.f;
#pragma unroll
      for (int v8 = 0; v8 < 8; ++v8) ss += oacc[v8][jj] * oacc[v8][jj];
      ss += __shfl_xor(ss, 1); ss += __shfl_xor(ss, 2); ss += __shfl_xor(ss, 4); ss += __shfl_xor(ss, 8);
      rs[jj] = rsqrtf(ss * (1.0f / 128.0f) + NORM_EPS);
    }
    {
      bf16 zgr[8][4];
#pragma unroll
      for (int v8 = 0; v8 < 8; ++v8)
#pragma unroll
        for (int jj = 0; jj < 4; ++jj)
          zgr[v8][jj] = z[(size_t)(tok0 + 16 * w + 4 * g + jj) * 5120 + 4096 + hd * 128 + v8 * 16 + r16];
      __builtin_amdgcn_sched_barrier(0);
#pragma unroll
      for (int v8 = 0; v8 < 8; ++v8) {
        const int col = hd * 128 + v8 * 16 + r16;
        const float ng = normg[col];
#pragma unroll
        for (int jj = 0; jj < 4; ++jj) {
          const int t = tok0 + 16 * w + 4 * g + jj;
          const float zg = bf2f(zgr[v8][jj]);
          const float val = oacc[v8][jj] * rs[jj] * ng * (zg * sigmoidf_(zg));
          og[(size_t)t * 1024 + col] = f2bf(val);
        }
      }
    }
  }
}

__device__ __forceinline__ void topk128(const bf16* __restrict__ sp, float (&top)[16]) {
#pragma unroll
  for (int p = 0; p < 16; ++p) top[p] = -INFINITY;
#pragma unroll 1
  for (int c8 = 0; c8 < 2; ++c8) {
    uint4 vv[8];
#pragma unroll
    for (int c = 0; c < 8; ++c) vv[c] = *(const uint4*)(sp + (c8 * 8 + c) * 8);
    __builtin_amdgcn_sched_barrier(0);
#pragma unroll
    for (int c = 0; c < 8; ++c) {
      const unsigned wv[4] = {vv[c].x, vv[c].y, vv[c].z, vv[c].w};
#pragma unroll
      for (int e = 0; e < 8; ++e) {
        const unsigned hbits = (e & 1) ? (wv[e >> 1] & 0xffff0000u) : (wv[e >> 1] << 16);
        const float x = __uint_as_float(hbits | (unsigned)((c8 * 8 + c) * 8 + e));
#pragma unroll
        for (int p = 15; p >= 1; --p) top[p] = __builtin_amdgcn_fmed3f(top[p - 1], top[p], x);
        top[0] = fmaxf(top[0], x);
      }
    }
  }
}
__device__ void peer_topk_phase(const bf16* __restrict__ s  , int* __restrict__ eidx, float* __restrict__ gate) {
  for (int idx = opaque_bid() * 256 + opaque_tid(); idx < T_TOK * 8; idx += gridDim.x * 256) {
    float t0[16], t1[16];
    topk128(s + (size_t)idx * 256, t0);
    topk128(s + (size_t)idx * 256 + 128, t1);
    float bs[16]; int be[16];
#pragma unroll
    for (int p = 0; p < 16; ++p) { bs[p] = -INFINITY; be[p] = 0; }
#pragma unroll
    for (int i = 0; i < 16; ++i)
#pragma unroll
      for (int j = 0; j < 16; ++j) {
        if ((i + 1) * (j + 1) <= 16) {
          const unsigned u0 = __float_as_uint(t0[i]), u1 = __float_as_uint(t1[j]);
          float x = __uint_as_float(u0 & ~127u) + __uint_as_float(u1 & ~127u);
          int xe = (int)((u0 & 127u) * 128u + (u1 & 127u));
#pragma unroll
          for (int p = 0; p < 16; ++p) {
            const bool c = x > bs[p];
            const float tv = c ? bs[p] : x;
            const int te = c ? be[p] : xe;
            bs[p] = c ? x : bs[p];
            be[p] = c ? xe : be[p];
            x = tv; xe = te;
          }
        }
      }
    float wgt[16], sum = 0.f;
#pragma unroll
    for (int p = 0; p < 16; ++p) { wgt[p] = __expf(bs[p] - bs[0]); sum += wgt[p]; }
    const float inv = 1.0f / sum;
#pragma unroll
    for (int p4 = 0; p4 < 4; ++p4) {
      *(int4*)(eidx + (size_t)idx * 16 + p4 * 4) = make_int4(be[p4 * 4], be[p4 * 4 + 1], be[p4 * 4 + 2], be[p4 * 4 + 3]);
      *(float4*)(gate + (size_t)idx * 16 + p4 * 4) = make_float4(wgt[p4 * 4] * inv, wgt[p4 * 4 + 1] * inv, wgt[p4 * 4 + 2] * inv, wgt[p4 * 4 + 3] * inv);
    }
  }
}

typedef float float2v __attribute__((ext_vector_type(2)));
__device__ __forceinline__ float dot16_fp8(int4 r, const float* x) {
  const int wv[4] = {r.x, r.y, r.z, r.w};
  float2v acc = {0.f, 0.f};
#pragma unroll
  for (int i = 0; i < 4; ++i) {
    const float2v lo = __builtin_amdgcn_cvt_pk_f32_fp8(wv[i], false);
    const float2v hi = __builtin_amdgcn_cvt_pk_f32_fp8(wv[i], true);
    const float2v x0 = {x[4 * i], x[4 * i + 1]}, x1 = {x[4 * i + 2], x[4 * i + 3]};
    acc = __builtin_elementwise_fma(lo, x0, acc);
    acc = __builtin_elementwise_fma(hi, x1, acc);
  }
  return acc.x + acc.y;
}
__device__ __forceinline__ void axpy16_fp8(float c, int4 r, float* y) {
  const int wv[4] = {r.x, r.y, r.z, r.w};
#pragma unroll
  for (int i = 0; i < 4; ++i) {
    const float2v lo = __builtin_amdgcn_cvt_pk_f32_fp8(wv[i], false);
    const float2v hi = __builtin_amdgcn_cvt_pk_f32_fp8(wv[i], true);
    y[4 * i] += c * lo.x; y[4 * i + 1] += c * lo.y; y[4 * i + 2] += c * hi.x; y[4 * i + 3] += c * hi.y;
  }
}
__device__ __forceinline__ int4 ld_row16(const unsigned char* rowp, unsigned loff) {
  asm volatile("" : "+s"(rowp));
  typedef int v4i_t __attribute__((ext_vector_type(4)));
  typedef const v4i_t __attribute__((address_space(1))) * gp_t;
  const v4i_t v = *(gp_t)(rowp + loff);
  return make_int4(v.x, v.y, v.z, v.w);
}
__device__ void peer_gather_phase(const float* __restrict__ h1, const unsigned char* __restrict__ ub, const unsigned char* __restrict__ vb,
                                  const float* __restrict__ usc, const float* __restrict__ vsc,
                                  const int* __restrict__ eidx, const float* __restrict__ gate, const float* __restrict__ gam,
                                  const float* __restrict__ bet, float* __restrict__ hout, bf16* __restrict__ hbf, char* smem) {
  const int tid = opaque_tid();
  const int bid_ = opaque_bid();
  const int lane = tid & 63;
  const int gw = bid_ * 4 + (tid >> 6), nw = gridDim.x * 4;
  const unsigned loff = (unsigned)lane * 16u;
  const int esel = lane >> 3;
  int* se = (int*)(smem + (tid >> 6) * 2048);
  float* sg = (float*)(se + 128);
  float* sc = sg + 128;
  for (int t = gw; t < T_TOK; t += nw) {
    float x[16], y[16];
    {
      const float* xr = h1 + (size_t)t * 1024 + lane * 16;
      float4 a0 = *(const float4*)xr, a1 = *(const float4*)(xr + 4), a2 = *(const float4*)(xr + 8), a3 = *(const float4*)(xr + 12);
      x[0] = a0.x; x[1] = a0.y; x[2] = a0.z; x[3] = a0.w; x[4] = a1.x; x[5] = a1.y; x[6] = a1.z; x[7] = a1.w;
      x[8] = a2.x; x[9] = a2.y; x[10] = a2.z; x[11] = a2.w; x[12] = a3.x; x[13] = a3.y; x[14] = a3.z; x[15] = a3.w;
    }
    int ereg0, ereg1;
    float gv0, gv1, iu0, iu1;
    {
      const int e0 = eidx[(size_t)t * 128 + lane], e1 = eidx[(size_t)t * 128 + 64 + lane];
      const float g0 = gate[(size_t)t * 128 + lane], g1 = gate[(size_t)t * 128 + 64 + lane];
      const int b0 = e0 >> 11, b1 = e1 >> 11;
      int rk0 = 0, rk1 = 0, base = 0;
#pragma unroll
      for (int bk = 0; bk < 8; ++bk) {
        const unsigned long long m0 = __ballot(b0 == bk), m1 = __ballot(b1 == bk);
        const int c0 = __popcll(m0), c1 = __popcll(m1);
        const int p0 = __builtin_amdgcn_mbcnt_hi((unsigned)(m0 >> 32), __builtin_amdgcn_mbcnt_lo((unsigned)m0, 0u));
        const int p1 = __builtin_amdgcn_mbcnt_hi((unsigned)(m1 >> 32), __builtin_amdgcn_mbcnt_lo((unsigned)m1, 0u));
        rk0 = (b0 == bk) ? (base + p0) : rk0;
        rk1 = (b1 == bk) ? (base + c0 + p1) : rk1;
        base += c0 + c1;
      }
      se[rk0] = e0; se[rk1] = e1; sg[rk0] = g0; sg[rk1] = g1;
      __builtin_amdgcn_fence(__ATOMIC_RELEASE, "wavefront");
      __builtin_amdgcn_wave_barrier();
      __builtin_amdgcn_fence(__ATOMIC_ACQUIRE, "wavefront");
      ereg0 = se[lane]; ereg1 = se[64 + lane];
      gv0 = sg[lane] * vsc[ereg0]; gv1 = sg[64 + lane] * vsc[ereg1];
      iu0 = usc[ereg0]; iu1 = usc[ereg1];
      __builtin_amdgcn_wave_barrier();
    }
#define G_LDROWS(DST, TBL, BT) do { const int es_ = ((BT) < 8) ? ereg0 : ereg1; const int eb_ = ((BT) & 7) * 8; \
      _Pragma("unroll") for (int k = 0; k < 8; ++k) { const int id_ = __builtin_amdgcn_readlane(es_, eb_ + k); DST[k] = ld_row16(TBL + (size_t)id_ * 1024, loff); } } while (0)
#define G_PASS1(SRC, BT) do { const int eb_ = ((BT) & 7) * 8; \
      float d_[8]; \
      _Pragma("unroll") for (int k = 0; k < 8; ++k) d_[k] = dot16_fp8(SRC[k], x); \
      float q4_[4], q2_[2], q1_; \
      _Pragma("unroll") for (int k = 0; k < 4; ++k) { \
        const auto r_ = __builtin_amdgcn_permlane32_swap(__float_as_uint(d_[k]), __float_as_uint(d_[k + 4]), false, false); \
        q4_[k] = __uint_as_float(r_[0]) + __uint_as_float(r_[1]); } \
      _Pragma("unroll") for (int k = 0; k < 2; ++k) { \
        const auto r_ = __builtin_amdgcn_permlane16_swap(__float_as_uint(q4_[k]), __float_as_uint(q4_[k + 2]), false, false); \
        q2_[k] = __uint_as_float(r_[0]) + __uint_as_float(r_[1]); } \
      { const bool hi_ = (lane & 8) != 0; const float keep_ = hi_ ? q2_[1] : q2_[0]; const float send_ = hi_ ? q2_[0] : q2_[1]; \
        q1_ = keep_ + __int_as_float(__builtin_amdgcn_update_dpp(0, __float_as_int(send_), 0x128, 0xF, 0xF, true)); } \
      q1_ += __int_as_float(__builtin_amdgcn_update_dpp(0, __float_as_int(q1_), 0xB1, 0xF, 0xF, true)); \
      q1_ += __int_as_float(__builtin_amdgcn_update_dpp(0, __float_as_int(q1_), 0x4E, 0xF, 0xF, true)); \
      q1_ += __int_as_float(__builtin_amdgcn_update_dpp(0, __float_as_int(q1_), 0x141, 0xF, 0xF, true)); \
      ddacc = ((((BT) & 7) == (lane & 7))) ? q1_ : ddacc; } while (0)
#define G_FINISH_HALF(HALF) do { const int slot_ = 8 * (lane & 7) + (lane >> 3); \
      const float dd_ = ddacc * __shfl((HALF) ? iu1 : iu0, slot_); \
      const float hid_ = 0.5f * dd_ * (1.0f + erff(dd_ * 0.7071067811865476f)); \
      sc[(HALF) * 64 + slot_] = hid_ * __shfl((HALF) ? gv1 : gv0, slot_); } while (0)
    float ddacc = 0.f;
    {
      int4 rA[8], rB[8];
      G_LDROWS(rA, ub, 0);
      __builtin_amdgcn_sched_barrier(0);
#pragma unroll 1
      for (int bt = 0; bt < 16; bt += 2) {
        G_LDROWS(rB, ub, bt + 1);
        __builtin_amdgcn_sched_barrier(0);
        G_PASS1(rA, bt);
        __builtin_amdgcn_sched_barrier(0);
        if (bt + 2 < 16) G_LDROWS(rA, ub, bt + 2);
        __builtin_amdgcn_sched_barrier(0);
        G_PASS1(rB, bt + 1);
        if (((bt + 1) & 7) == 7) G_FINISH_HALF(bt >> 3);
        __builtin_amdgcn_sched_barrier(0);
      }
    }
    __builtin_amdgcn_fence(__ATOMIC_RELEASE, "wavefront");
    __builtin_amdgcn_wave_barrier();
    __builtin_amdgcn_fence(__ATOMIC_ACQUIRE, "wavefront");
    const float cf0 = sc[lane], cf1 = sc[64 + lane];
    __builtin_amdgcn_wave_barrier();
#pragma unroll
    for (int i = 0; i < 16; ++i) y[i] = 0.f;
#define G_PASS2(SRC, BT) do { const int eb_ = ((BT) & 7) * 8; const int cs_ = __float_as_int(((BT) < 8) ? cf0 : cf1); \
      _Pragma("unroll") for (int k = 0; k < 8; ++k) { const float c_ = __int_as_float(__builtin_amdgcn_readlane(cs_, eb_ + k)); axpy16_fp8(c_, SRC[k], y); } } while (0)
    {
      int4 rA[8];
#pragma unroll 1
      for (int bt = 0; bt < 16; ++bt) {
        G_LDROWS(rA, vb, bt);
        __builtin_amdgcn_sched_barrier(0);
        G_PASS2(rA, bt);
        __builtin_amdgcn_sched_barrier(0);
      }
    }
    {
      const float* xr = h1 + (size_t)t * 1024 + lane * 16;
      float4 a0 = *(const float4*)xr, a1 = *(const float4*)(xr + 4), a2 = *(const float4*)(xr + 8), a3 = *(const float4*)(xr + 12);
      asm volatile("" : "+v"(a0.x), "+v"(a1.x), "+v"(a2.x), "+v"(a3.x));
      x[0] = a0.x; x[1] = a0.y; x[2] = a0.z; x[3] = a0.w; x[4] = a1.x; x[5] = a1.y; x[6] = a1.z; x[7] = a1.w;
      x[8] = a2.x; x[9] = a2.y; x[10] = a2.z; x[11] = a2.w; x[12] = a3.x; x[13] = a3.y; x[14] = a3.z; x[15] = a3.w;
    }
    float sm = 0.f;
#pragma unroll
    for (int i = 0; i < 16; ++i) { y[i] = DN_ALPHA * x[i] + y[i]; sm += y[i]; }
    const float mu = wave_sum(sm) * (1.0f / 1024.0f);
    float qq = 0.f;
#pragma unroll
    for (int i = 0; i < 16; ++i) { const float dd = y[i] - mu; qq += dd * dd; }
    const float rstd = rsqrtf(wave_sum(qq) * (1.0f / 1024.0f) + NORM_EPS);
    const int col = lane * 16;
    float o[16];
#pragma unroll
    for (int c4 = 0; c4 < 4; ++c4) {
      const float4 g0 = *(const float4*)(gam + col + c4 * 4), b0 = *(const float4*)(bet + col + c4 * 4);
      o[c4 * 4 + 0] = (y[c4 * 4 + 0] - mu) * rstd * g0.x + b0.x; o[c4 * 4 + 1] = (y[c4 * 4 + 1] - mu) * rstd * g0.y + b0.y;
      o[c4 * 4 + 2] = (y[c4 * 4 + 2] - mu) * rstd * g0.z + b0.z; o[c4 * 4 + 3] = (y[c4 * 4 + 3] - mu) * rstd * g0.w + b0.w;
      *(float4*)(hout + (size_t)t * 1024 + col + c4 * 4) = make_float4(o[c4 * 4], o[c4 * 4 + 1], o[c4 * 4 + 2], o[c4 * 4 + 3]);
    }
    *(uint4*)(hbf + (size_t)t * 1024 + col) = make_uint4(pack2(o[0], o[1]), pack2(o[2], o[3]), pack2(o[4], o[5]), pack2(o[6], o[7]));
    *(uint4*)(hbf + (size_t)t * 1024 + col + 8) = make_uint4(pack2(o[8], o[9]), pack2(o[10], o[11]), pack2(o[12], o[13]), pack2(o[14], o[15]));
  }
}

#define XB_TMO      128
#define XB_XCNT(j)  (256  + 64 * (j))
#define XB_XSUB(j)  (1280 + 64 * (j))
#define XB_XGEN(j)  (2304 + 64 * (j))
#define XB_TOP      3328
#define XB_TOPGEN   3392
#define XCD_BAR_WORDS 3456
#define XB_SPIN_CAP (1u << 22)
#define LAS __attribute__((address_space(3)))
__device__ __forceinline__ unsigned xb_ld(unsigned* p) { return __hip_atomic_load(p, __ATOMIC_RELAXED, __HIP_MEMORY_SCOPE_AGENT); }
__device__ __forceinline__ unsigned xb_add(unsigned* p, unsigned v) { return __hip_atomic_fetch_add(p, v, __ATOMIC_RELAXED, __HIP_MEMORY_SCOPE_AGENT); }
__device__ __forceinline__ unsigned xb_xcc_id() { return (unsigned)__builtin_amdgcn_s_getreg((3 << 11) | 20) & 0xFu; }
#define XB_SPIN(cond, bar) do { unsigned _sp = 0; while (cond) { __builtin_amdgcn_s_sleep(1); \
    if ((++_sp & 255u) == 0u) { if (xb_ld(&(bar)[XB_TMO])) break; if (_sp > XB_SPIN_CAP) { atomicAdd(&(bar)[XB_TMO], 1u); break; } } } } while (0)
struct XcdBarrier { unsigned* bar; unsigned x; volatile LAS unsigned* st; };
__device__ __forceinline__ XcdBarrier xcd_barrier_post(unsigned* bar, volatile LAS unsigned* st) {
  XcdBarrier b; b.bar = bar; b.x = xb_xcc_id(); b.st = st;
  if (threadIdx.x == 0) (void)xb_add(&bar[XB_XCNT(b.x)], 1u);
  return b;
}
__device__ __forceinline__ void xcd_barrier_complete(unsigned* bar, unsigned x, unsigned& nloc, unsigned& nx) {
  const unsigned G = gridDim.x * gridDim.y * gridDim.z;
  unsigned sum, cnt, mine, sp = 0u;
  for (;;) {
    sum = 0u; cnt = 0u; mine = 0u;
#pragma unroll
    for (unsigned j = 0; j < 16; ++j) { const unsigned c = xb_ld(&bar[XB_XCNT(j)]); sum += c; cnt += (c > 0u) ? 1u : 0u; mine = (j == x) ? c : mine; }
    if (sum == G) break;
    __builtin_amdgcn_s_sleep(1);
    if ((++sp & 255u) == 0u) { if (xb_ld(&bar[XB_TMO])) break; if (sp > XB_SPIN_CAP) { atomicAdd(&bar[XB_TMO], 1u); break; } }
  }
  nloc = mine > 0u ? mine : 1u; nx = cnt > 0u ? cnt : 1u;
}
__device__ __forceinline__ void xcd_barrier(const XcdBarrier& b) {
  asm volatile("s_waitcnt vmcnt(0)" ::: "memory");
  __syncthreads();
  if (threadIdx.x == 0) {
    unsigned* bar = b.bar;
    asm volatile("" : "+s"(bar));
    __builtin_amdgcn_s_waitcnt(0);
    unsigned nloc = b.st[0], nx = b.st[1];
    if (nloc == 0u) { xcd_barrier_complete(bar, b.x, nloc, nx); b.st[0] = nloc; b.st[1] = nx; }
    const unsigned old = xb_add(&bar[XB_XSUB(b.x)], 1u);
    const unsigned gen = old / nloc;
    if (old + 1u == (gen + 1u) * nloc) {
      __builtin_amdgcn_fence(__ATOMIC_RELEASE, "agent");
      asm volatile("s_waitcnt vmcnt(0)" ::: "memory");
      const unsigned og = xb_add(&bar[XB_TOP], 1u);
      const unsigned tg = og / nx;
      if (og + 1u == (tg + 1u) * nx) xb_add(&bar[XB_TOPGEN], 1u);
      else XB_SPIN(xb_ld(&bar[XB_TOPGEN]) == tg, bar);
      __builtin_amdgcn_fence(__ATOMIC_ACQUIRE, "agent");
      xb_add(&bar[XB_XGEN(b.x)], 1u);
      asm volatile("s_waitcnt vmcnt(0)" ::: "memory");
    } else {
      XB_SPIN(xb_ld(&bar[XB_XGEN(b.x)]) == gen, bar);
      __builtin_amdgcn_fence(__ATOMIC_ACQUIRE, "agent");
      asm volatile("s_waitcnt vmcnt(0)" ::: "memory");
    }
  }
  __syncthreads();
}

#define SMEM_BYTES 61440
__global__ void __launch_bounds__(256, 2) mega_kernel(Params p) {
  __shared__ __attribute__((aligned(16))) char smem[SMEM_BYTES + 16];
  cg::grid_group grid = cg::this_grid();
  char* ws = p.ws;
  bf16* na_in_t = (bf16*)(ws + OFF_NA_IN_T);
  bf16* na_out_t = (bf16*)(ws + OFF_NA_OUT_T);
  bf16* mla_in_t = (bf16*)(ws + OFF_MLA_IN_T);
  bf16* mla_qup_t = (bf16*)(ws + OFF_MLA_QUP_T);
  bf16* mla_kvup_t = (bf16*)(ws + OFF_MLA_KVUP_T);
  bf16* mla_out_t = (bf16*)(ws + OFF_MLA_OUT_T);
  bf16* hg_in_t = (bf16*)(ws + OFF_HG_IN_T);
  bf16* hg_out_t = (bf16*)(ws + OFF_HG_OUT_T);
  bf16* peer_wq_t = (bf16*)(ws + OFF_PEER_WQ_T);
  bf16* peer_keys = (bf16*)(ws + OFF_PEER_KEYS);
  unsigned char* ub = (unsigned char*)(ws + OFF_UB);
  unsigned char* vb = (unsigned char*)(ws + OFF_VB);
  float* usc = (float*)(ws + OFF_USC);
  float* vsc = (float*)(ws + OFF_VSC);
  float* hA = (float*)(ws + OFF_HA);
  float* hB = (float*)(ws + OFF_HB);
  bf16* hbf = (bf16*)(ws + OFF_HBF);
  float* mix = (float*)(ws + OFF_MIX);
  char* R1 = ws + OFF_R1;
  char* R2 = ws + OFF_R2;
  bf16* obf = (bf16*)(ws + OFF_OBF);
  int* eidx = (int*)(ws + OFF_EIDX);
  float* gate = (float*)(ws + OFF_GATE);
  bf16* vtb = (bf16*)(ws + OFF_VT);
  float* dec = (float*)(ws + OFF_DEC);
  float* lbv = (float*)(ws + OFF_LB);
  float* ropet = (float*)(ws + OFF_ROPE);
  unsigned* bar = (unsigned*)(ws + OFF_BAR);
  if (threadIdx.x == 0) *(uint4*)(smem + SMEM_BYTES) = make_uint4(0u, 0u, 0u, 0u);
  __syncthreads();
  XcdBarrier xb = xcd_barrier_post(bar, (volatile LAS unsigned*)(smem + SMEM_BYTES));

  if (gridDim.x == 0x7fffffffu) grid.sync();

#pragma unroll 1
  for (int layer = 0; layer < 4; ++layer) {
    const int kind = layer % 3;
    const int j = layer / 3;
    const float* hin = (layer == 0) ? p.in[0] : hB;
    bf16* qk = (bf16*)R1;
    float* hmla = (float*)R1;
    bf16* qb = (bf16*)(R1 + (size_t)T_TOK * 640 * 4);
    bf16* knb = qb + (size_t)T_TOK * 1536;
    bf16* cqn = (bf16*)R2;
    bf16* ckvn = cqn + (size_t)T_TOK * 256;
    bf16* kpe = ckvn + (size_t)T_TOK * 256;
    bf16* z = (bf16*)R1;
    bf16* local = (bf16*)R2;
    bf16* pq = (bf16*)R1;
    bf16* psb = (bf16*)R2;
#pragma unroll 1
    for (int sub = (layer == 0) ? -1 : 0; sub < 10; ++sub) {
      bool did = true;
      switch (sub) {
        case -1: {
      #pragma unroll 1
        for (int job = 0; job < 14; ++job) {
          const float* src; bf16* dst; int K = 1024, N = 1024, Np = 1024;
          switch (job) {
            case 0: case 1: src = p.in[1] + (size_t)job * 1024 * 3072; dst = na_in_t + (size_t)job * 3072 * 1024; N = 3072; Np = 3072; break;
            case 2: case 3: src = p.in[3] + (size_t)(job - 2) * 1024 * 1024; dst = na_out_t + (size_t)(job - 2) * 1024 * 1024; break;
            case 4: src = p.in[4]; dst = mla_in_t; N = 544; Np = 640; break;
            case 5: src = p.in[7]; dst = mla_qup_t; K = 256; N = 1536; Np = 1536; break;
            case 6: src = p.in[8]; dst = mla_kvup_t; K = 256; N = 2048; Np = 2048; break;
            case 7: src = p.in[9]; dst = mla_out_t; break;
            case 8: src = p.in[10]; dst = hg_in_t; N = 5120; Np = 5120; break;
            case 9: src = p.in[13]; dst = hg_out_t; break;
            default: src = p.in[14] + (size_t)(job - 10) * 1024 * 2048; dst = peer_wq_t + (size_t)(job - 10) * 2048 * 1024; N = 2048; Np = 2048; break;
          }
          transpose_cvt(src, dst, K, N, Np, smem);
        }
        cvt_bf16(p.in[15], peer_keys, (size_t)4 * 2 * 128 * 128);
        cvt_fp8_rows(p.in[16], ub, usc, 4 * 16384);
        cvt_fp8_rows(p.in[17], vb, vsc, 4 * 16384);
        cvt_bf16(p.in[0], hbf, (size_t)T_TOK * 1024);
        for (int i = opaque_bid() * 256 + opaque_tid(); i < 4096 * 16; i += gridDim.x * 256) {
          const float invf = powf(10000.0f, -(float)(i & 15) * (1.0f / 16.0f));
          const float ang = (float)(i >> 4) * invf;
          ropet[i] = cosf(ang);
          ropet[4096 * 16 + i] = sinf(ang);
        }
        {
          const float* lbp = p.in[11];
          for (int i = opaque_bid() * 256 + opaque_tid(); i < 2048; i += gridDim.x * 256) {
            float a0 = lbp[i], a1 = lbp[2048 + i], a2 = lbp[4096 + i], a3 = lbp[6144 + i];
            float mx = fmaxf(fmaxf(a0, a1), fmaxf(a2, a3));
            float e0 = expf(a0 - mx), e1 = expf(a1 - mx), e2 = expf(a2 - mx), e3 = expf(a3 - mx);
            lbv[i] = (e1 + e2) / (e0 + e1 + e2 + e3);
          }
        }
        } break;
        case 0:
          if (kind == 0) gemm_bt<8>(hbf, 1024, na_in_t + (size_t)j * 3072 * 1024, 1024, T_TOK, 3072, 1024, EpiNAqkv{qk, vtb}, smem);
          else if (kind == 1) gemm_bt<4>(hbf, 1024, mla_in_t, 1024, T_TOK, 640, 1024, EpiF32{hmla, 640}, smem);
          else gemm_bt<8>(hbf, 1024, hg_in_t, 1024, T_TOK, 5120, 1024, EpiHGin{z, vtb}, smem);
          break;
        case 1:
          if (kind == 0) na_attn_phase(qk, vtb, p.in[2] + (size_t)j * 16 * 15 * 31, obf, smem);
          else if (kind == 1) mla_prep_phase(hmla, ropet, p.in[5], p.in[6], cqn, ckvn, kpe);
          else hg_local_phase(z, vtb, lbv, local, dec, smem);
          break;
        case 2:
          if (kind == 1) {
            gemm_bt<8>(cqn, 256, mla_qup_t, 256, T_TOK, 1536, 256, EpiBF16{qb, 1536}, smem);
            gemm_bt<8>(ckvn, 256, mla_kvup_t, 256, T_TOK, 2048, 256, EpiMLAkv{knb, vtb}, smem);
          } else if (kind == 2) hg_prefix_phase(local, dec);
          else did = false;
          break;
        case 3:
          if (kind == 1) mla_attn_phase(qb, knb, kpe, vtb, obf, ropet, smem);
          else if (kind == 2) hg_out_phase(z, vtb, lbv, local, p.in[12], obf, smem);
          else did = false;
          break;
        case 4: {
          const bf16* wo = (kind == 0) ? (na_out_t + (size_t)j * 1024 * 1024) : (kind == 1) ? mla_out_t : hg_out_t;
          gemm_bt<8>(obf, 1024, wo, 1024, T_TOK, 1024, 1024, EpiF32{mix, 1024}, smem);
        } break;
        case 5:
          ln_phase(hin, mix, p.in[18] + layer * 1024, p.in[19] + layer * 1024, hA, hbf);
          break;
        case 6:
          gemm_bt<8>(hbf, 1024, peer_wq_t + (size_t)layer * 2048 * 1024, 1024, T_TOK, 2048, 1024, EpiBF16{pq, 2048}, smem);
          break;
        case 7:
#pragma unroll 1
          for (int c = 0; c < 2; ++c)
            gemm_bt<4>(pq + c * 128, 256, peer_keys + (size_t)(layer * 2 + c) * 128 * 128, 128, T_TOK * 8, 128, 128, EpiBF16{psb + c * 128, 256}, smem);
          break;
        case 8:
          peer_topk_phase(psb, eidx, gate);
          break;
        default: {
          float* hout = (layer == 3) ? p.out : hB;
          peer_gather_phase(hA, ub + (size_t)layer * 16384 * 1024, vb + (size_t)layer * 16384 * 1024, usc + layer * 16384, vsc + layer * 16384,
                            eidx, gate, p.in[20] + layer * 1024, p.in[21] + layer * 1024, hout, hbf, smem);
        } break;
      }
      if (did && !(layer == 3 && sub == 9)) xcd_barrier(xb);
    }
  }
}

extern "C" void kernel_launch(void* const* d_in, const int* in_sizes, int n_in, void* d_out, int out_size, void* d_ws,
                              size_t ws_size, hipStream_t stream) {
  static int grid_blocks = 0;
  if (!grid_blocks) {
    int dev = 0, cus = 0, per_cu = 0;
    hipGetDevice(&dev);
    hipDeviceGetAttribute(&cus, hipDeviceAttributeMultiprocessorCount, dev);
    hipOccupancyMaxActiveBlocksPerMultiprocessor(&per_cu, mega_kernel, 256, 0);
    if (per_cu < 1) per_cu = 1;
    if (per_cu > 2) per_cu = 2;
    grid_blocks = cus * per_cu;
  }
  Params p{};
  for (int i = 0; i < 22; ++i) p.in[i] = (const float*)d_in[i];
  p.out = (float*)d_out;
  p.ws = (char*)d_ws;
  hipMemsetAsync((char*)d_ws + OFF_BAR, 0, 16384, stream);
  void* args[] = {&p};
  hipError_t e = hipLaunchCooperativeKernel((void*)mega_kernel, dim3(grid_blocks), dim3(256), args, 0, stream);
  if (e != hipSuccess) fprintf(stderr, "cooperative launch failed: %s (grid %d)\n", hipGetErrorString(e), grid_blocks);
}
```

```cpp
#include <hip/hip_runtime.h>
#include <hip/hip_cooperative_groups.h>
#include <stdint.h>
#include <cstdio>
namespace cg = cooperative_groups;

typedef unsigned short bf16;
using bf16x8 = __attribute__((ext_vector_type(8))) short;
using f32x4 = __attribute__((ext_vector_type(4))) float;

#define T_TOK 16384
#define SEQ 4096
#define DN_ALPHA 1.681792830507429f
#define NORM_EPS 1e-5f

constexpr size_t al256(size_t x) { return (x + 255) & ~(size_t)255; }
constexpr size_t SZ_NA_IN_T = (size_t)2 * 3072 * 1024 * 2;
constexpr size_t SZ_NA_OUT_T = (size_t)2 * 1024 * 1024 * 2;
constexpr size_t SZ_MLA_IN_T = (size_t)640 * 1024 * 2;
constexpr size_t SZ_MLA_QUP_T = (size_t)1536 * 256 * 2;
constexpr size_t SZ_MLA_KVUP_T = (size_t)2048 * 256 * 2;
constexpr size_t SZ_MLA_OUT_T = (size_t)1024 * 1024 * 2;
constexpr size_t SZ_HG_IN_T = (size_t)5120 * 1024 * 2;
constexpr size_t SZ_HG_OUT_T = (size_t)1024 * 1024 * 2;
constexpr size_t SZ_PEER_WQ_T = (size_t)4 * 2048 * 1024 * 2;
constexpr size_t SZ_PEER_KEYS = (size_t)4 * 2 * 128 * 128 * 2;
constexpr size_t SZ_UB = (size_t)4 * 16384 * 1024;
constexpr size_t SZ_USC = (size_t)4 * 16384 * 4;
constexpr size_t SZ_HF32 = (size_t)T_TOK * 1024 * 4;
constexpr size_t SZ_HBF = (size_t)T_TOK * 1024 * 2;
constexpr size_t SZ_R1 = (size_t)T_TOK * 5120 * 2;
constexpr size_t SZ_R2 = (size_t)T_TOK * 8 * 256 * 4;
constexpr size_t SZ_EIDX = (size_t)T_TOK * 128 * 4;
constexpr size_t SZ_DEC = (size_t)2048 * 2 * 128 * 4;
constexpr size_t SZ_LB = (size_t)2 * 1024 * 4;

constexpr size_t OFF_NA_IN_T = 0;
constexpr size_t OFF_NA_OUT_T = OFF_NA_IN_T + al256(SZ_NA_IN_T);
constexpr size_t OFF_MLA_IN_T = OFF_NA_OUT_T + al256(SZ_NA_OUT_T);
constexpr size_t OFF_MLA_QUP_T = OFF_MLA_IN_T + al256(SZ_MLA_IN_T);
constexpr size_t OFF_MLA_KVUP_T = OFF_MLA_QUP_T + al256(SZ_MLA_QUP_T);
constexpr size_t OFF_MLA_OUT_T = OFF_MLA_KVUP_T + al256(SZ_MLA_KVUP_T);
constexpr size_t OFF_HG_IN_T = OFF_MLA_OUT_T + al256(SZ_MLA_OUT_T);
constexpr size_t OFF_HG_OUT_T = OFF_HG_IN_T + al256(SZ_HG_IN_T);
constexpr size_t OFF_PEER_WQ_T = OFF_HG_OUT_T + al256(SZ_HG_OUT_T);
constexpr size_t OFF_PEER_KEYS = OFF_PEER_WQ_T + al256(SZ_PEER_WQ_T);
constexpr size_t OFF_UB = OFF_PEER_KEYS + al256(SZ_PEER_KEYS);
constexpr size_t OFF_VB = OFF_UB + al256(SZ_UB);
constexpr size_t OFF_HA = OFF_VB + al256(SZ_UB);
constexpr size_t OFF_HB = OFF_HA + al256(SZ_HF32);
constexpr size_t OFF_HBF = OFF_HB + al256(SZ_HF32);
constexpr size_t OFF_MIX = OFF_HBF + al256(SZ_HBF);
constexpr size_t OFF_R1 = OFF_MIX + al256(SZ_HF32);
constexpr size_t OFF_R2 = OFF_R1 + al256(SZ_R1);
constexpr size_t OFF_OBF = OFF_R2 + al256(SZ_R2);
constexpr size_t OFF_EIDX = OFF_OBF + al256(SZ_HBF);
constexpr size_t OFF_GATE = OFF_EIDX + al256(SZ_EIDX);
constexpr size_t OFF_VT = OFF_GATE + al256(SZ_EIDX);
constexpr size_t OFF_DEC = OFF_VT + al256(SZ_HBF);
constexpr size_t OFF_LB = OFF_DEC + al256(SZ_DEC);
constexpr size_t OFF_ROPE = OFF_LB + al256(SZ_LB);
constexpr size_t OFF_USC = OFF_ROPE + (size_t)2 * 4096 * 16 * 4;
constexpr size_t OFF_VSC = OFF_USC + al256(SZ_USC);
constexpr size_t OFF_BAR = OFF_VSC + al256(SZ_USC);
constexpr size_t WS_TOTAL = OFF_BAR + 16384;
static_assert(WS_TOTAL < ((size_t)1 << 30), "workspace must stay under 1 GiB");

struct Params {
  const float* in[22];
  float* out;
  char* ws;
};

typedef __bf16 hwbf2 __attribute__((ext_vector_type(2)));
typedef float hwf2 __attribute__((ext_vector_type(2)));
__device__ __forceinline__ unsigned pack2(float a, float b) {
  hwf2 v = {a, b};
  hwbf2 r = __builtin_convertvector(v, hwbf2);
  return __builtin_bit_cast(unsigned, r);
}
__device__ __forceinline__ bf16 f2bf(float f) { return (bf16)(pack2(f, 0.f) & 0xffffu); }
__device__ __forceinline__ float bf2f(bf16 h) { return __uint_as_float(((unsigned)h) << 16); }
__device__ __forceinline__ float bflo(unsigned w) { return __uint_as_float(w << 16); }
__device__ __forceinline__ float bfhi(unsigned w) { return __uint_as_float(w & 0xffff0000u); }
__device__ __forceinline__ int opaque_tid() {
  int t = threadIdx.x;
  asm volatile("" : "+v"(t));
  return t;
}
__device__ __forceinline__ int opaque_bid() {
  int b = blockIdx.x;
  asm volatile("" : "+s"(b));
  return b;
}
__device__ __forceinline__ float red_max_x32(float v) { const auto r = __builtin_amdgcn_permlane32_swap(__float_as_uint(v), __float_as_uint(v), false, false); return fmaxf(__uint_as_float(r[0]), __uint_as_float(r[1])); }
__device__ __forceinline__ float red_max_x16(float v) { const auto r = __builtin_amdgcn_permlane16_swap(__float_as_uint(v), __float_as_uint(v), false, false); return fmaxf(__uint_as_float(r[0]), __uint_as_float(r[1])); }
__device__ __forceinline__ float red_sum_x32(float v) { const auto r = __builtin_amdgcn_permlane32_swap(__float_as_uint(v), __float_as_uint(v), false, false); return __uint_as_float(r[0]) + __uint_as_float(r[1]); }
__device__ __forceinline__ float red_sum_x16(float v) { const auto r = __builtin_amdgcn_permlane16_swap(__float_as_uint(v), __float_as_uint(v), false, false); return __uint_as_float(r[0]) + __uint_as_float(r[1]); }
__device__ __forceinline__ float wave_sum(float v) {
  v = red_sum_x32(v);
  v = red_sum_x16(v);
  v += __int_as_float(__builtin_amdgcn_update_dpp(0, __float_as_int(v), 0x128, 0xF, 0xF, true));
  v += __int_as_float(__builtin_amdgcn_update_dpp(0, __float_as_int(v), 0xB1, 0xF, 0xF, true));
  v += __int_as_float(__builtin_amdgcn_update_dpp(0, __float_as_int(v), 0x4E, 0xF, 0xF, true));
  v += __int_as_float(__builtin_amdgcn_update_dpp(0, __float_as_int(v), 0x141, 0xF, 0xF, true));
  return v;
}
__device__ __forceinline__ float sigmoidf_(float x) { return __builtin_amdgcn_rcpf(1.0f + __expf(-x)); }
__device__ __forceinline__ f32x4 mfma16(bf16x8 a, bf16x8 b, f32x4 c) {
  return __builtin_amdgcn_mfma_f32_16x16x32_bf16(a, b, c, 0, 0, 0);
}
union U4B8 { uint4 u; bf16x8 v; };
__device__ __forceinline__ bf16x8 ld_frag16(const bf16* p) { U4B8 t; t.u = *(const uint4*)p; return t.v; }
__device__ __forceinline__ bf16x8 ld_frag8x2(const bf16* p0, const bf16* p1) {
  uint2 a = *(const uint2*)p0, b = *(const uint2*)p1;
  U4B8 t; t.u = make_uint4(a.x, a.y, b.x, b.y); return t.v;
}

__device__ void transpose_cvt(const float* __restrict__ src, bf16* __restrict__ dst, int K, int N, int Npad, char* smem) {
  float* tile = (float*)smem;
  const int tid = opaque_tid();
  const int bid_ = opaque_bid();
  const int tn_cnt = Npad >> 6, tk_cnt = K >> 6;
  const int ntiles = tn_cnt * tk_cnt;
  typedef float f4v_t __attribute__((ext_vector_type(4)));
  for (int t = bid_; t < ntiles; t += gridDim.x) {
    const int tk = t / tn_cnt, tn = t % tn_cnt;
#pragma unroll
    for (int i = 0; i < 4; ++i) {
      const int c = tid + 256 * i, kr = c >> 4, nq = c & 15;
      const int n = tn * 64 + nq * 4;
      f4v_t v = {0.f, 0.f, 0.f, 0.f};
      if (n < N) v = __builtin_nontemporal_load((const f4v_t*)(src + (size_t)(tk * 64 + kr) * N + n));
      float* tp = tile + kr * 65 + nq * 4;
      tp[0] = v.x; tp[1] = v.y; tp[2] = v.z; tp[3] = v.w;
    }
    __syncthreads();
#pragma unroll
    for (int i = 0; i < 2; ++i) {
      const int c = tid + 256 * i, nn = c >> 3, kc = c & 7;
      const float* tp = tile + (kc * 8) * 65 + nn;
      const uint4 o = make_uint4(pack2(tp[0], tp[65]), pack2(tp[2 * 65], tp[3 * 65]), pack2(tp[4 * 65], tp[5 * 65]), pack2(tp[6 * 65], tp[7 * 65]));
      *(uint4*)(dst + (size_t)(tn * 64 + nn) * K + tk * 64 + kc * 8) = o;
    }
    __syncthreads();
  }
}

__device__ void cvt_bf16(const float* __restrict__ src, bf16* __restrict__ dst, size_t n) {
  const size_t n8 = n >> 3;
  const size_t stride = (size_t)gridDim.x * 256;
  for (size_t i = (size_t)opaque_bid() * 256 + opaque_tid(); i < n8; i += stride) {
    float4 a = ((const float4*)src)[2 * i], b = ((const float4*)src)[2 * i + 1];
    uint4 o = make_uint4(pack2(a.x, a.y), pack2(a.z, a.w), pack2(b.x, b.y), pack2(b.z, b.w));
    ((uint4*)dst)[i] = o;
  }
}


__device__ void cvt_fp8_rows(const float* __restrict__ src, unsigned char* __restrict__ dst, float* __restrict__ isc, int nrows) {
  const int tid = opaque_tid();
  const int bid_ = opaque_bid();
  const int lane = tid & 63;
  const int gw = bid_ * 4 + (tid >> 6), nw = gridDim.x * 4;
  for (int row0 = gw * 2; row0 < nrows; row0 += nw * 2) {
    float4 v[2][4];
#pragma unroll
    for (int r = 0; r < 2; ++r)
#pragma unroll
      for (int c = 0; c < 4; ++c) {
        typedef float f4v_t __attribute__((ext_vector_type(4)));
        const f4v_t t_ = __builtin_nontemporal_load((const f4v_t*)(src + (size_t)(row0 + r) * 1024 + c * 256 + lane * 4));
        v[r][c] = make_float4(t_.x, t_.y, t_.z, t_.w);
      }
#pragma unroll
    for (int r = 0; r < 2; ++r) {
      float m = 0.f;
#pragma unroll
      for (int c = 0; c < 4; ++c) m = fmaxf(m, fmaxf(fmaxf(fabsf(v[r][c].x), fabsf(v[r][c].y)), fmaxf(fabsf(v[r][c].z), fabsf(v[r][c].w))));
#pragma unroll
      for (int o = 32; o >= 1; o >>= 1) m = fmaxf(m, __shfl_xor(m, o));
      const float sc = (m > 0.f) ? exp2f(floorf(log2f(240.0f / m))) : 1.0f;
#pragma unroll
      for (int c = 0; c < 4; ++c) {
        int wv = 0;
        wv = __builtin_amdgcn_cvt_pk_fp8_f32(v[r][c].x * sc, v[r][c].y * sc, wv, false);
        wv = __builtin_amdgcn_cvt_pk_fp8_f32(v[r][c].z * sc, v[r][c].w * sc, wv, true);
        *(int*)(dst + (size_t)(row0 + r) * 1024 + c * 256 + lane * 4) = wv;
      }
      if (lane == 0) isc[row0 + r] = 1.0f / sc;
    }
  }
}

struct EpiF32 {
  float* C; int ldc;
  __device__ __forceinline__ void operator()(int row, int col, f32x4 v) const {
#pragma unroll
    for (int j = 0; j < 4; ++j) C[(size_t)(row + j) * ldc + col] = v[j];
  }
};
struct EpiBF16 {
  bf16* C; int ldc;
  __device__ __forceinline__ void operator()(int row, int col, f32x4 v) const {
#pragma unroll
    for (int j = 0; j < 4; ++j) C[(size_t)(row + j) * ldc + col] = f2bf(v[j]);
  }
};
struct EpiNAqkv {
  bf16* qk; bf16* vt;
  __device__ __forceinline__ void operator()(int row, int col, f32x4 v) const {
    if (col < 2048) {
#pragma unroll
      for (int j = 0; j < 4; ++j) qk[(size_t)(row + j) * 2048 + col] = f2bf(v[j]);
    } else {
      const int c = col - 2048, head = c >> 6, d = c & 63, b = row >> 12, s = row & 4095;
      uint2 o = make_uint2(pack2(v[0], v[1]), pack2(v[2], v[3]));
      *(uint2*)(vt + ((size_t)((b * 16 + head) * 64 + d)) * SEQ + s) = o;
    }
  }
};
struct EpiMLAkv {
  bf16* kn; bf16* vt;
  __device__ __forceinline__ void operator()(int row, int col, f32x4 v) const {
    const int head = col >> 7, wi = col & 127, b = row >> 12, s = row & 4095;
    if (wi < 64) {
#pragma unroll
      for (int j = 0; j < 4; ++j) kn[((size_t)((b * 16 + head) * SEQ + s + j)) * 64 + wi] = f2bf(v[j]);
    } else {
      uint2 o = make_uint2(pack2(v[0], v[1]), pack2(v[2], v[3]));
      *(uint2*)(vt + ((size_t)((b * 16 + head) * 64 + (wi - 64))) * SEQ + s) = o;
    }
  }
};
struct EpiHGin {
  bf16* z; bf16* vt;
  __device__ __forceinline__ void operator()(int row, int col, f32x4 v) const {
#pragma unroll
    for (int j = 0; j < 4; ++j) z[(size_t)(row + j) * 5120 + col] = f2bf(v[j]);
    if (col >= 3072 && col < 4096) {
      const int c = col - 3072, head = c >> 7, vv = c & 127, b = row >> 12, s = row & 4095;
      uint2 o = make_uint2(pack2(v[0], v[1]), pack2(v[2], v[3]));
      *(uint2*)(vt + ((size_t)((b * 8 + head) * 128 + vv)) * SEQ + s) = o;
    }
  }
};

#define GEMM_LDS_STRIDE 40
template <int NT, class Epi>
__device__ __forceinline__ void gemm_bt(const bf16* __restrict__ A, int lda, const bf16* __restrict__ Bt, int ldb,
                                        int M, int N, int K, const Epi& epi, char* smem) {
  constexpr int BN = 32 * NT;
  constexpr int NB = BN / 64;
  const int tid = opaque_tid(), lane = tid & 63, w = tid >> 6;
  const int bid_ = opaque_bid();
  const int wm = w >> 1, wn = w & 1;
  const int g = lane >> 4, r16 = lane & 15;
  bf16* sA = (bf16*)smem;
  bf16* sB = sA + 2 * 128 * GEMM_LDS_STRIDE;
  const int tilesN = N / BN;
  const int ntiles = (M >> 7) * tilesN;
  const int nk = K >> 5;
  const int lrow = tid >> 2, lkc = (tid & 3) * 8;
  const bool xsw = ((gridDim.x & 7) == 0) && (((M >> 7) & 7) == 0);
  const int t_first = xsw ? (bid_ >> 3) : bid_;
  const int t_step = xsw ? (int)(gridDim.x >> 3) : (int)gridDim.x;
  const int t_cnt = xsw ? (ntiles >> 3) : ntiles;
  for (int tq = t_first; tq < t_cnt; tq += t_step) {
    const int rbq = tq / tilesN;
    const int m0 = (xsw ? (rbq * 8 + (bid_ & 7)) : rbq) << 7, n0 = (tq % tilesN) * BN;
    f32x4 acc[4][NT];
#pragma unroll
    for (int i = 0; i < 4; ++i)
#pragma unroll
      for (int j = 0; j < NT; ++j) acc[i][j] = (f32x4){0.f, 0.f, 0.f, 0.f};
    const bf16* gA = A + (size_t)(m0 + lrow) * lda + lkc;
    const bf16* gB = Bt + (size_t)(n0 + lrow) * ldb + lkc;
    uint4 ra0, ra1, rb0, rb1, rb2, rb3;
#define GEMM_GLOAD(KO) do { \
      ra0 = *(const uint4*)(gA + (KO)); ra1 = *(const uint4*)(gA + (size_t)64 * lda + (KO)); \
      rb0 = *(const uint4*)(gB + (KO)); rb1 = *(const uint4*)(gB + (size_t)64 * ldb + (KO)); \
      if constexpr (NB == 4) { rb2 = *(const uint4*)(gB + (size_t)128 * ldb + (KO)); rb3 = *(const uint4*)(gB + (size_t)192 * ldb + (KO)); } } while (0)
#define GEMM_LSTORE(BUF) do { \
      bf16* dA_ = sA + (BUF) * 128 * GEMM_LDS_STRIDE + lrow * GEMM_LDS_STRIDE + lkc; \
      bf16* dB_ = sB + (BUF) * BN * GEMM_LDS_STRIDE + lrow * GEMM_LDS_STRIDE + lkc; \
      *(uint4*)dA_ = ra0; *(uint4*)(dA_ + 64 * GEMM_LDS_STRIDE) = ra1; \
      *(uint4*)dB_ = rb0; *(uint4*)(dB_ + 64 * GEMM_LDS_STRIDE) = rb1; \
      if constexpr (NB == 4) { *(uint4*)(dB_ + 128 * GEMM_LDS_STRIDE) = rb2; *(uint4*)(dB_ + 192 * GEMM_LDS_STRIDE) = rb3; } } while (0)
    GEMM_GLOAD(0);
    GEMM_LSTORE(0);
    __syncthreads();
    for (int kt = 0; kt < nk; ++kt) {
      const int cur = kt & 1;
      if (kt + 1 < nk) GEMM_GLOAD((kt + 1) * 32);
      const bf16* a_base = sA + cur * 128 * GEMM_LDS_STRIDE + (wm * 64 + r16) * GEMM_LDS_STRIDE + g * 8;
      const bf16* b_base = sB + cur * BN * GEMM_LDS_STRIDE + (wn * (16 * NT) + r16) * GEMM_LDS_STRIDE + g * 8;
      bf16x8 af[4];
#pragma unroll
      for (int i = 0; i < 4; ++i) af[i] = ld_frag16(a_base + i * 16 * GEMM_LDS_STRIDE);
#pragma unroll
      for (int jh = 0; jh < NT / 4; ++jh) {
        bf16x8 bfr[4];
#pragma unroll
        for (int j = 0; j < 4; ++j) bfr[j] = ld_frag16(b_base + (jh * 4 + j) * 16 * GEMM_LDS_STRIDE);
        __builtin_amdgcn_s_setprio(1);
#pragma unroll
        for (int i = 0; i < 4; ++i)
#pragma unroll
          for (int j = 0; j < 4; ++j) acc[i][jh * 4 + j] = mfma16(af[i], bfr[j], acc[i][jh * 4 + j]);
        __builtin_amdgcn_s_setprio(0);
      }
      if (kt + 1 < nk) GEMM_LSTORE(cur ^ 1);
      __syncthreads();
    }
#pragma unroll
    for (int i = 0; i < 4; ++i)
#pragma unroll
      for (int j = 0; j < NT; ++j) epi(m0 + wm * 64 + i * 16 + g * 4, n0 + wn * (16 * NT) + j * 16 + r16, acc[i][j]);
  }
}

__device__ void ln_phase(const float* __restrict__ hin, const float* __restrict__ mix, const float* __restrict__ gam,
                         const float* __restrict__ bet, float* __restrict__ hout, bf16* __restrict__ hbf) {
  const int tid = opaque_tid();
  const int bid_ = opaque_bid();
  const int lane = tid & 63;
  const int gw = bid_ * 4 + (tid >> 6), nw = gridDim.x * 4;
  for (int row = gw; row < T_TOK; row += nw) {
    float v[16];
    float s = 0.f;
#pragma unroll
    for (int c = 0; c < 4; ++c) {
      const size_t o = (size_t)row * 1024 + c * 256 + lane * 4;
      typedef float f4v_t __attribute__((ext_vector_type(4)));
      const f4v_t a_ = __builtin_nontemporal_load((const f4v_t*)(hin + o)), m_ = __builtin_nontemporal_load((const f4v_t*)(mix + o));
      const float4 a = make_float4(a_.x, a_.y, a_.z, a_.w), m = make_float4(m_.x, m_.y, m_.z, m_.w);
      v[c * 4 + 0] = DN_ALPHA * a.x + m.x; v[c * 4 + 1] = DN_ALPHA * a.y + m.y;
      v[c * 4 + 2] = DN_ALPHA * a.z + m.z; v[c * 4 + 3] = DN_ALPHA * a.w + m.w;
      s += v[c * 4 + 0] + v[c * 4 + 1] + v[c * 4 + 2] + v[c * 4 + 3];
    }
    const float mu = wave_sum(s) * (1.0f / 1024.0f);
    float q = 0.f;
#pragma unroll
    for (int i = 0; i < 16; ++i) { float d = v[i] - mu; q += d * d; }
    const float rstd = rsqrtf(wave_sum(q) * (1.0f / 1024.0f) + NORM_EPS);
#pragma unroll
    for (int c = 0; c < 4; ++c) {
      const int col = c * 256 + lane * 4;
      float4 gg = *(const float4*)(gam + col), bb = *(const float4*)(bet + col);
      float4 o;
      o.x = (v[c * 4 + 0] - mu) * rstd * gg.x + bb.x; o.y = (v[c * 4 + 1] - mu) * rstd * gg.y + bb.y;
      o.z = (v[c * 4 + 2] - mu) * rstd * gg.z + bb.z; o.w = (v[c * 4 + 3] - mu) * rstd * gg.w + bb.w;
      *(float4*)(hout + (size_t)row * 1024 + col) = o;
      *(uint2*)(hbf + (size_t)row * 1024 + col) = make_uint2(pack2(o.x, o.y), pack2(o.z, o.w));
    }
  }
}

__device__ void na_attn_phase(const bf16* __restrict__ qk, const bf16* __restrict__ vt, const float* __restrict__ rel_bias,
                              bf16* __restrict__ o, char* smem) {
  const int tid = opaque_tid();
  const int bid_ = opaque_bid();
  const int lane = tid & 63, w = tid >> 6, g = lane >> 4, r16 = lane & 15;
  const int s0 = (w == 0) ? 0 : (w == 1) ? 8 : (w == 2) ? 24 : 32;
  const int wq = 16 * w + r16;
  const int c0 = min(max(wq - 8, 0), 48);
  const bool xsw = (gridDim.x & 7) == 0;
  const int i_first = xsw ? (bid_ >> 3) : bid_;
  const int i_step = xsw ? (int)(gridDim.x >> 3) : (int)gridDim.x;
  const int i_cnt = xsw ? 512 : 4096;
  for (int iq = i_first; iq < i_cnt; iq += i_step) {
    const int item = xsw ? (((((iq >> 6) << 3) + (bid_ & 7)) << 6) + (iq & 63)) : iq;
    const int pair_ = xsw ? (item >> 6) : (((item >> 10) << 4) | (item & 15));
    const int head = pair_ & 15, r = xsw ? (item & 63) : ((item >> 4) & 63), b = pair_ >> 4;
    const int r0 = min(max(r - 4, 0), 56);
    float* sb = (float*)smem;
    __syncthreads();
    for (int i = tid; i < 480; i += 256) {
      const int rr = i >> 5, cc = i & 31;
      sb[i] = (cc < 31) ? rel_bias[(head * 15 + rr) * 31 + cc] * 1.4426950408889634f : 0.f;
    }
    __syncthreads();
    const int tq = b * SEQ + r * 64 + wq;
    bf16x8 qf[2];
#pragma unroll
    for (int ks = 0; ks < 2; ++ks) qf[ks] = ld_frag16(qk + (size_t)tq * 2048 + head * 64 + ks * 32 + g * 8);
    f32x4 st[8][2];
#pragma unroll
    for (int kr2 = 0; kr2 < 4; ++kr2) {
      bf16x8 ka[8];
#pragma unroll
      for (int q = 0; q < 8; ++q) {
        const int kr = kr2 * 2 + (q >> 2), kt = (q >> 1) & 1, ks = q & 1;
        const int tk = b * SEQ + (r0 + kr) * 64 + s0 + 8 * (r16 >> 2) + 4 * kt + (r16 & 3);
        ka[q] = ld_frag16(qk + (size_t)tk * 2048 + 1024 + head * 64 + ks * 32 + g * 8);
      }
      __builtin_amdgcn_sched_barrier(0);
#pragma unroll
      for (int q = 0; q < 8; q += 2) {
        const int kr = kr2 * 2 + (q >> 2), kt = (q >> 1) & 1;
        f32x4 acc = (f32x4){0.f, 0.f, 0.f, 0.f};
        acc = mfma16(ka[q], qf[0], acc);
        acc = mfma16(ka[q + 1], qf[1], acc);
        st[kr][kt] = acc;
      }
      __builtin_amdgcn_sched_barrier(0);
    }
    float mx = -INFINITY;
#pragma unroll
    for (int kr = 0; kr < 8; ++kr)
#pragma unroll
      for (int kt = 0; kt < 2; ++kt)
#pragma unroll
        for (int jj = 0; jj < 4; ++jj) {
          const int kc = s0 + 8 * g + 4 * kt + jj;
          const bool valid = (kc >= c0) && (kc < c0 + 16);
          const int dr = r0 + kr - r + 7;
          const int dc = min(max(kc - wq + 15, 0), 30);
          float bias = sb[dr * 32 + dc];
          asm volatile("" : "+v"(bias));
          const float val = valid ? fmaf(st[kr][kt][jj], 0.125f * 1.4426950408889634f, bias) : -INFINITY;
          st[kr][kt][jj] = val;
          mx = fmaxf(mx, val);
        }
    mx = red_max_x16(mx);
    mx = red_max_x32(mx);
    float sum = 0.f;
#pragma unroll
    for (int kr = 0; kr < 8; ++kr)
#pragma unroll
      for (int kt = 0; kt < 2; ++kt)
#pragma unroll
        for (int jj = 0; jj < 4; ++jj) {
          const float pv = __builtin_amdgcn_exp2f(st[kr][kt][jj] - mx);
          st[kr][kt][jj] = pv;
          sum += pv;
        }
    sum = red_sum_x16(sum);
    sum = red_sum_x32(sum);
    f32x4 oacc[4];
#pragma unroll
    for (int dt = 0; dt < 4; ++dt) oacc[dt] = (f32x4){0.f, 0.f, 0.f, 0.f};
#pragma unroll
    for (int kr2 = 0; kr2 < 4; ++kr2) {
      bf16x8 va[8];
#pragma unroll
      for (int q = 0; q < 8; ++q) {
        const int kr = kr2 * 2 + (q >> 2), dt = q & 3;
        va[q] = ld_frag16(vt + ((size_t)((b * 16 + head) * 64 + dt * 16 + r16)) * SEQ + (r0 + kr) * 64 + s0 + 8 * g);
      }
      __builtin_amdgcn_sched_barrier(0);
#pragma unroll
      for (int q = 0; q < 8; ++q) {
        const int kr = kr2 * 2 + (q >> 2), dt = q & 3;
        U4B8 pb;
        pb.u = make_uint4(pack2(st[kr][0][0], st[kr][0][1]), pack2(st[kr][0][2], st[kr][0][3]),
                          pack2(st[kr][1][0], st[kr][1][1]), pack2(st[kr][1][2], st[kr][1][3]));
        oacc[dt] = mfma16(va[q], pb.v, oacc[dt]);
      }
      __builtin_amdgcn_sched_barrier(0);
    }
    const float inv = 1.0f / sum;
#pragma unroll
    for (int dt = 0; dt < 4; ++dt) {
      uint2 ov = make_uint2(pack2(oacc[dt][0] * inv, oacc[dt][1] * inv), pack2(oacc[dt][2] * inv, oacc[dt][3] * inv));
      *(uint2*)(o + (size_t)tq * 1024 + head * 64 + dt * 16 + 4 * g) = ov;
    }
  }
}

__device__ void mla_prep_phase(const float* __restrict__ hin  , const float* __restrict__ rope, const float* __restrict__ qn, const float* __restrict__ kvn,
                               bf16* __restrict__ cqn, bf16* __restrict__ ckvn, bf16* __restrict__ kpe) {
  const int tid = opaque_tid();
  const int bid_ = opaque_bid();
  const int lane = tid & 63;
  const int gw = bid_ * 4 + (tid >> 6), nw = gridDim.x * 4;
  for (int t = gw; t < T_TOK; t += nw) {
    const float* row = hin + (size_t)t * 640;
    float4 a = *(const float4*)(row + lane * 4);
    float4 c = *(const float4*)(row + 256 + lane * 4);
    float sa = wave_sum(a.x * a.x + a.y * a.y + a.z * a.z + a.w * a.w);
    float sc = wave_sum(c.x * c.x + c.y * c.y + c.z * c.z + c.w * c.w);
    const float ra = rsqrtf(sa * (1.0f / 256.0f) + NORM_EPS), rc = rsqrtf(sc * (1.0f / 256.0f) + NORM_EPS);
    float4 ga = *(const float4*)(qn + lane * 4), gc = *(const float4*)(kvn + lane * 4);
    *(uint2*)(cqn + (size_t)t * 256 + lane * 4) = make_uint2(pack2(a.x * ra * ga.x, a.y * ra * ga.y), pack2(a.z * ra * ga.z, a.w * ra * ga.w));
    *(uint2*)(ckvn + (size_t)t * 256 + lane * 4) = make_uint2(pack2(c.x * rc * gc.x, c.y * rc * gc.y), pack2(c.z * rc * gc.z, c.w * rc * gc.w));
    if (lane < 16) {
      const float x1 = row[512 + lane], x2 = row[528 + lane];
      const float cs = rope[(t & 4095) * 16 + lane], sn = rope[4096 * 16 + (t & 4095) * 16 + lane];
      kpe[(size_t)t * 32 + lane] = f2bf(x1 * cs - x2 * sn);
      kpe[(size_t)t * 32 + 16 + lane] = f2bf(x1 * sn + x2 * cs);
    }
  }
}

#define MLA_KS 104
#define MLA_VS 72
__device__ void mla_attn_phase(const bf16* __restrict__ q  , const bf16* __restrict__ kn  ,
                               const bf16* __restrict__ kpe  , const bf16* __restrict__ vt  ,
                               bf16* __restrict__ o  , const float* __restrict__ rope, char* smem) {
  const int tid = opaque_tid(), lane = tid & 63, w = tid >> 6, g = lane >> 4, r16 = lane & 15;
  const int bid_ = opaque_bid();
  bf16* sK = (bf16*)smem;
  bf16* sV = sK + 2 * 64 * MLA_KS;
  const float sc2 = 0.10206207261596575f * 1.4426950408889634f;
  const bool xsw = (gridDim.x & 7) == 0;
  const int i_first = xsw ? (bid_ >> 3) : bid_;
  const int i_step = xsw ? (int)(gridDim.x >> 3) : (int)gridDim.x;
  const int i_cnt = xsw ? 256 : 2048;
  for (int iq = i_first; iq < i_cnt; iq += i_step) {
    const int item = xsw ? (((((iq >> 5) << 3) + (bid_ & 7)) << 5) + (iq & 31)) : iq;
    const int qb = item & 31, head = (item >> 5) & 15, b = item >> 9;
    const int bh = b * 16 + head;
    bf16x8 qf[2][3];
#pragma unroll
    for (int qt = 0; qt < 2; ++qt) {
      const int tq = b * SEQ + qb * 128 + w * 32 + qt * 16 + r16;
      const bf16* qrow = q + (size_t)tq * 1536 + head * 96;
      qf[qt][0] = ld_frag16(qrow + g * 8);
      qf[qt][1] = ld_frag16(qrow + 32 + g * 8);
      const int i0 = 8 * (g & 1);
      uint4 x1r = *(const uint4*)(qrow + 64 + i0), x2r = *(const uint4*)(qrow + 80 + i0);
      const unsigned x1w[4] = {x1r.x, x1r.y, x1r.z, x1r.w}, x2w[4] = {x2r.x, x2r.y, x2r.z, x2r.w};
      float res[8];
      const float* cp = rope + (tq & 4095) * 16 + i0;
      const float4 c0 = *(const float4*)cp, c1 = *(const float4*)(cp + 4);
      const float4 s0 = *(const float4*)(cp + 4096 * 16), s1 = *(const float4*)(cp + 4096 * 16 + 4);
      const float csv[8] = {c0.x, c0.y, c0.z, c0.w, c1.x, c1.y, c1.z, c1.w};
      const float snv[8] = {s0.x, s0.y, s0.z, s0.w, s1.x, s1.y, s1.z, s1.w};
#pragma unroll
      for (int j = 0; j < 8; ++j) {
        const float x1 = (j & 1) ? bfhi(x1w[j >> 1]) : bflo(x1w[j >> 1]);
        const float x2 = (j & 1) ? bfhi(x2w[j >> 1]) : bflo(x2w[j >> 1]);
        res[j] = (g < 2) ? (x1 * csv[j] - x2 * snv[j]) : (x1 * snv[j] + x2 * csv[j]);
      }
      U4B8 t; t.u = make_uint4(pack2(res[0], res[1]), pack2(res[2], res[3]), pack2(res[4], res[5]), pack2(res[6], res[7]));
      qf[qt][2] = t.v;
    }
    uint4 rk0, rk1, rk2, rv0, rv1;
    const bf16* kn_b = kn + (size_t)bh * SEQ * 64;
    const bf16* kpe_b = kpe + (size_t)b * SEQ * 32;
    const bf16* vt_b = vt + (size_t)bh * 64 * SEQ;
    const unsigned ko = (unsigned)tid * 8u;
    const unsigned vo0 = (unsigned)(tid >> 3) * SEQ + (unsigned)(tid & 7) * 8u;
    const unsigned vo1 = vo0 + 32u * SEQ;
    auto gload = [&](int kt) {
      const bf16* kb = kn_b + (size_t)kt * 64 * 64;
      const bf16* pb_ = kpe_b + (size_t)kt * 64 * 32;
      const bf16* vb_ = vt_b + (size_t)kt * 64;
      asm volatile("" : "+s"(kb), "+s"(pb_), "+s"(vb_));
      typedef unsigned v4u_t __attribute__((ext_vector_type(4)));
      typedef const v4u_t __attribute__((address_space(1))) * gp_t;
      const v4u_t t0 = *(gp_t)(kb + ko), t1 = *(gp_t)(kb + ko + 2048u), t2 = *(gp_t)(pb_ + ko), t3 = *(gp_t)(vb_ + vo0), t4 = *(gp_t)(vb_ + vo1);
      rk0 = make_uint4(t0.x, t0.y, t0.z, t0.w); rk1 = make_uint4(t1.x, t1.y, t1.z, t1.w); rk2 = make_uint4(t2.x, t2.y, t2.z, t2.w);
      rv0 = make_uint4(t3.x, t3.y, t3.z, t3.w); rv1 = make_uint4(t4.x, t4.y, t4.z, t4.w);
    };
    auto lstore = [&](int buf) {
      bf16* dk = sK + buf * 64 * MLA_KS;
      *(uint4*)(dk + (tid >> 3) * MLA_KS + (tid & 7) * 8) = rk0;
      *(uint4*)(dk + (32 + (tid >> 3)) * MLA_KS + (tid & 7) * 8) = rk1;
      *(uint4*)(dk + (tid >> 2) * MLA_KS + 64 + (tid & 3) * 8) = rk2;
      bf16* dv = sV + buf * 64 * MLA_VS;
      *(uint4*)(dv + (tid >> 3) * MLA_VS + (tid & 7) * 8) = rv0;
      *(uint4*)(dv + (32 + (tid >> 3)) * MLA_VS + (tid & 7) * 8) = rv1;
    };
    gload(0);
    lstore(0);
    __syncthreads();
    float m_[2] = {-INFINITY, -INFINITY}, l_[2] = {0.f, 0.f};
    f32x4 oacc[2][4];
#pragma unroll
    for (int qt = 0; qt < 2; ++qt)
#pragma unroll
      for (int dt = 0; dt < 4; ++dt) oacc[qt][dt] = (f32x4){0.f, 0.f, 0.f, 0.f};
#pragma unroll 1
    for (int kt = 0; kt < 64; ++kt) {
      const int cur = kt & 1;
      if (kt + 1 < 64) gload(kt + 1);
      f32x4 s[2][4];
#pragma unroll
      for (int qt = 0; qt < 2; ++qt)
#pragma unroll
        for (int k4 = 0; k4 < 4; ++k4) s[qt][k4] = (f32x4){0.f, 0.f, 0.f, 0.f};
      __builtin_amdgcn_s_setprio(1);
#pragma unroll
      for (int k4 = 0; k4 < 4; ++k4)
#pragma unroll
        for (int ks = 0; ks < 3; ++ks) {
          bf16x8 a = ld_frag16(sK + cur * 64 * MLA_KS + (32 * (k4 >> 1) + 8 * (r16 >> 2) + 4 * (k4 & 1) + (r16 & 3)) * MLA_KS + ks * 32 + g * 8);
#pragma unroll
          for (int qt = 0; qt < 2; ++qt) s[qt][k4] = mfma16(a, qf[qt][ks], s[qt][k4]);
        }
      __builtin_amdgcn_s_setprio(0);
      bf16x8 pb[2][2];
#pragma unroll
      for (int qt = 0; qt < 2; ++qt) {
        float mx = -INFINITY;
#pragma unroll
        for (int k4 = 0; k4 < 4; ++k4)
#pragma unroll
          for (int jj = 0; jj < 4; ++jj) mx = fmaxf(mx, s[qt][k4][jj]);
        mx = red_max_x16(mx);
        mx = red_max_x32(mx);
        const float mxs = mx * sc2;
        if (__builtin_amdgcn_ballot_w64(mxs > m_[qt] + 11.541560327111707f) != 0ull) {
          const float mnew = fmaxf(m_[qt], mxs);
          const float alpha = __builtin_amdgcn_exp2f(m_[qt] - mnew);
          m_[qt] = mnew;
          l_[qt] *= alpha;
#pragma unroll
          for (int dt = 0; dt < 4; ++dt)
#pragma unroll
            for (int jj = 0; jj < 4; ++jj) oacc[qt][dt][jj] *= alpha;
        }
        const float mcur = m_[qt];
        float ps = 0.f;
#pragma unroll
        for (int k4 = 0; k4 < 4; ++k4)
#pragma unroll
          for (int jj = 0; jj < 4; ++jj) { const float pv = __builtin_amdgcn_exp2f(fmaf(s[qt][k4][jj], sc2, -mcur)); s[qt][k4][jj] = pv; ps += pv; }
        l_[qt] += ps;
#pragma unroll
        for (int kk = 0; kk < 2; ++kk) {
          U4B8 t;
          t.u = make_uint4(pack2(s[qt][2 * kk][0], s[qt][2 * kk][1]), pack2(s[qt][2 * kk][2], s[qt][2 * kk][3]),
                           pack2(s[qt][2 * kk + 1][0], s[qt][2 * kk + 1][1]), pack2(s[qt][2 * kk + 1][2], s[qt][2 * kk + 1][3]));
          pb[qt][kk] = t.v;
        }
      }
      __builtin_amdgcn_s_setprio(1);
#pragma unroll
      for (int dt = 0; dt < 4; ++dt)
#pragma unroll
        for (int kk = 0; kk < 2; ++kk) {
          const bf16* base = sV + cur * 64 * MLA_VS + (dt * 16 + r16) * MLA_VS + kk * 32 + 8 * g;
          bf16x8 a = ld_frag16(base);
#pragma unroll
          for (int qt = 0; qt < 2; ++qt) oacc[qt][dt] = mfma16(a, pb[qt][kk], oacc[qt][dt]);
        }
      __builtin_amdgcn_s_setprio(0);
      if (kt + 1 < 64) lstore(cur ^ 1);
      __syncthreads();
    }
#pragma unroll
    for (int qt = 0; qt < 2; ++qt) {
      float ls = l_[qt];
      ls = red_sum_x16(ls);
      ls = red_sum_x32(ls);
      const float inv = 1.0f / ls;
      const int tq = b * SEQ + qb * 128 + w * 32 + qt * 16 + r16;
#pragma unroll
      for (int dt = 0; dt < 4; ++dt) {
        uint2 ov = make_uint2(pack2(oacc[qt][dt][0] * inv, oacc[qt][dt][1] * inv), pack2(oacc[qt][dt][2] * inv, oacc[qt][dt][3] * inv));
        *(uint2*)(o + (size_t)tq * 1024 + head * 64 + dt * 16 + 4 * g) = ov;
      }
    }
  }
}

#define HG_KS 72
#define HG_QS 136
#define HG_AS 72
__device__ void hg_local_phase(const bf16* __restrict__ z, const bf16* __restrict__ vt, const float* __restrict__ lbv,
                               bf16* __restrict__ local, float* __restrict__ dec, char* smem) {
  const int tid = opaque_tid(), lane = tid & 63, w = tid >> 6, g = lane >> 4, r16 = lane & 15;
  const int bid_ = opaque_bid();
  bf16* sZ = (bf16*)smem;
  bf16* sKl = sZ + 64 * HG_QS;
  float* sTot = (float*)(sKl + 128 * HG_KS);
  for (int item = bid_; item < 2048; item += gridDim.x) {
    const int n = item & 63, hd = (item >> 6) & 7, b = item >> 9;
    const int tok0 = b * SEQ + n * 64;
#pragma unroll 1
    for (int dir = 0; dir < 2; ++dir) {
#pragma unroll
      for (int i = 0; i < 4; ++i) {
        const int c = tid + 256 * i, row = c >> 4, cc = c & 15;
        *(uint4*)(sZ + row * HG_QS + cc * 8) = *(const uint4*)(z + (size_t)(tok0 + row) * 5120 + (1 + dir) * 1024 + hd * 128 + cc * 8);
      }
      __syncthreads();
      {
        const int f = tid & 127, half = tid >> 7, hbase = half * 32;
        const int first = dir ? 0 : 1;
        const float lb = lbv[dir * 1024 + hd * 128 + f];
        float lfv[32];
        float tot = 0.f;
#pragma unroll
        for (int i = 0; i < 32; ++i) {
          const int t = dir ? (hbase + i) : (hbase + 31 - i);
          const float zf = bf2f(sZ[t * HG_QS + f]);
          const float sg = sigmoidf_(zf);
          lfv[i] = __logf(lb + (1.0f - lb) * sg);
          tot += lfv[i];
        }
        sTot[half * 128 + f] = tot;
        __syncthreads();
        float run = (half == first) ? 0.f : sTot[first * 128 + f];
#pragma unroll
        for (int i = 0; i < 32; ++i) {
          const int t = dir ? (hbase + i) : (hbase + 31 - i);
          sKl[f * HG_KS + t] = f2bf((1.0f - __expf(lfv[i])) * __expf(run));
          run += lfv[i];
        }
        if (half != first) dec[(size_t)(item * 2 + dir) * 128 + f] = __expf(run);
      }
      __syncthreads();
      f32x4 acc[2][8];
#pragma unroll
      for (int fi = 0; fi < 2; ++fi)
#pragma unroll
        for (int v8 = 0; v8 < 8; ++v8) acc[fi][v8] = (f32x4){0.f, 0.f, 0.f, 0.f};
#pragma unroll
      for (int kk = 0; kk < 2; ++kk) {
        bf16x8 a[2];
#pragma unroll
        for (int fi = 0; fi < 2; ++fi) a[fi] = ld_frag16(sKl + ((2 * w + fi) * 16 + r16) * HG_KS + kk * 32 + g * 8);
#pragma unroll
        for (int v8 = 0; v8 < 8; ++v8) {
          bf16x8 bb = ld_frag16(vt + ((size_t)((b * 8 + hd) * 128 + v8 * 16 + r16)) * SEQ + n * 64 + kk * 32 + g * 8);
#pragma unroll
          for (int fi = 0; fi < 2; ++fi) acc[fi][v8] = mfma16(a[fi], bb, acc[fi][v8]);
        }
      }
      bf16* lp = local + (size_t)(item * 2 + dir) * 16384;
#pragma unroll
      for (int fi = 0; fi < 2; ++fi)
#pragma unroll
        for (int v8 = 0; v8 < 8; ++v8) {
          uint2 o = make_uint2(pack2(acc[fi][v8][0], acc[fi][v8][1]), pack2(acc[fi][v8][2], acc[fi][v8][3]));
          *(uint2*)(lp + (v8 * 16 + r16) * 128 + (2 * w + fi) * 16 + 4 * g) = o;
        }
      __syncthreads();
    }
  }
}
__device__ void hg_prefix_phase(bf16* __restrict__ local, const float* __restrict__ dec) {
  const int total = 64 * 2048;
  for (int idx = opaque_bid() * 256 + opaque_tid(); idx < total; idx += gridDim.x * 256) {
    const int chain = idx >> 11, e8 = idx & 2047;
    const int bh = chain >> 1, dir = chain & 1;
    const int f0 = (e8 * 8) & 127;
    float r[8];
#pragma unroll
    for (int j = 0; j < 8; ++j) r[j] = 0.f;
#pragma unroll 8
    for (int i = 0; i < 64; ++i) {
      const int n = dir ? 63 - i : i;
      const size_t idn = (size_t)((bh * 64 + n) * 2 + dir);
      uint4* ptr = (uint4*)(local + idn * 16384 + (size_t)e8 * 8);
      const uint4 raw = *ptr;
      const float4 d0 = *(const float4*)(dec + idn * 128 + f0), d1 = *(const float4*)(dec + idn * 128 + f0 + 4);
      *ptr = make_uint4(pack2(r[0], r[1]), pack2(r[2], r[3]), pack2(r[4], r[5]), pack2(r[6], r[7]));
      r[0] = d0.x * r[0] + bflo(raw.x); r[1] = d0.y * r[1] + bfhi(raw.x);
      r[2] = d0.z * r[2] + bflo(raw.y); r[3] = d0.w * r[3] + bfhi(raw.y);
      r[4] = d1.x * r[4] + bflo(raw.z); r[5] = d1.y * r[5] + bfhi(raw.z);
      r[6] = d1.z * r[6] + bflo(raw.w); r[7] = d1.w * r[7] + bfhi(raw.w);
    }
  }
}
__device__ void hg_out_phase(const bf16* __restrict__ z, const bf16* __restrict__ vt, const float* __restrict__ lbv,
                             const bf16* __restrict__ state, const float* __restrict__ normg, bf16* __restrict__ og, char* smem) {
  const int tid = opaque_tid(), lane = tid & 63, w = tid >> 6, g = lane >> 4, r16 = lane & 15;
  const int bid_ = opaque_bid();
  bf16* sQ = (bf16*)smem;
  bf16* sKd = sQ + 64 * HG_QS;
  bf16* sAt = sKd + 64 * HG_QS;
  float* sTot = (float*)(sAt + 64 * HG_AS);
  for (int item = bid_; item < 2048; item += gridDim.x) {
    const int n = item & 63, hd = (item >> 6) & 7, b = item >> 9;
    const int tok0 = b * SEQ + n * 64;
    f32x4 oacc[8];
#pragma unroll
    for (int v8 = 0; v8 < 8; ++v8) oacc[v8] = (f32x4){0.f, 0.f, 0.f, 0.f};
#pragma unroll 1
    for (int dir = 0; dir < 2; ++dir) {
#pragma unroll
      for (int i = 0; i < 4; ++i) {
        const int c = tid + 256 * i, row = c >> 4, cc = c & 15;
        const bf16* zr = z + (size_t)(tok0 + row) * 5120 + hd * 128 + cc * 8;
        *(uint4*)(sQ + row * HG_QS + cc * 8) = *(const uint4*)zr;
        *(uint4*)(sKd + row * HG_QS + cc * 8) = *(const uint4*)(zr + (1 + dir) * 1024);
      }
      __syncthreads();
      {
        const int f = tid & 127, half = tid >> 7, hbase = half * 32;
        const int first = dir ? 1 : 0;
        const float lb = lbv[dir * 1024 + hd * 128 + f];
        float lfv[32];
        float tot = 0.f;
#pragma unroll
        for (int i = 0; i < 32; ++i) {
          const int t = dir ? (hbase + 31 - i) : (hbase + i);
          const float zf = bf2f(sKd[t * HG_QS + f]);
          const float sg = sigmoidf_(zf);
          lfv[i] = __logf(lb + (1.0f - lb) * sg);
          tot += lfv[i];
        }
        sTot[half * 128 + f] = tot;
        __syncthreads();
        float run = (half == first) ? 0.f : sTot[first * 128 + f];
#pragma unroll
        for (int i = 0; i < 32; ++i) {
          const int t = dir ? (hbase + 31 - i) : (hbase + i);
          run += lfv[i];
          const float zz = bf2f(sQ[t * HG_QS + f]);
          const float qv = zz * sigmoidf_(zz);
          sQ[t * HG_QS + f] = f2bf(qv * __expf(run));
          sKd[t * HG_QS + f] = f2bf((1.0f - __expf(lfv[i])) * __expf(-run));
        }
      }
      __syncthreads();
      {
        f32x4 a4[4];
#pragma unroll
        for (int st = 0; st < 4; ++st) a4[st] = (f32x4){0.f, 0.f, 0.f, 0.f};
#pragma unroll
        for (int kk = 0; kk < 4; ++kk) {
          bf16x8 a = ld_frag16(sQ + (16 * w + r16) * HG_QS + kk * 32 + g * 8);
#pragma unroll
          for (int st = 0; st < 4; ++st) {
            bf16x8 bb = ld_frag16(sKd + (16 * st + r16) * HG_QS + kk * 32 + g * 8);
            a4[st] = mfma16(a, bb, a4[st]);
          }
        }
#pragma unroll
        for (int st = 0; st < 4; ++st)
#pragma unroll
          for (int jj = 0; jj < 4; ++jj) {
            const int t = 16 * w + 4 * g + jj, s = 16 * st + r16;
            const bool keep = dir ? (s >= t) : (s <= t);
            sAt[t * HG_AS + s] = f2bf(keep ? a4[st][jj] : 0.f);
          }
      }
      __syncthreads();
#pragma unroll 1
      for (int kk = 0; kk < 2; ++kk) {
        bf16x8 a = ld_frag16(sAt + (16 * w + r16) * HG_AS + kk * 32 + g * 8);
        bf16x8 bb[8];
#pragma unroll
        for (int v8 = 0; v8 < 8; ++v8) bb[v8] = ld_frag16(vt + ((size_t)((b * 8 + hd) * 128 + v8 * 16 + r16)) * SEQ + n * 64 + kk * 32 + g * 8);
        __builtin_amdgcn_sched_barrier(0);
#pragma unroll
        for (int v8 = 0; v8 < 8; ++v8) oacc[v8] = mfma16(a, bb[v8], oacc[v8]);
        __builtin_amdgcn_sched_barrier(0);
      }
      const bf16* sp = state + (size_t)(item * 2 + dir) * 16384;
#pragma unroll 1
      for (int kk = 0; kk < 4; ++kk) {
        bf16x8 a = ld_frag16(sQ + (16 * w + r16) * HG_QS + kk * 32 + g * 8);
        bf16x8 bb[8];
#pragma unroll
        for (int v8 = 0; v8 < 8; ++v8) bb[v8] = ld_frag16(sp + (v8 * 16 + r16) * 128 + kk * 32 + g * 8);
        __builtin_amdgcn_sched_barrier(0);
#pragma unroll
        for (int v8 = 0; v8 < 8; ++v8) oacc[v8] = mfma16(a, bb[v8], oacc[v8]);
        __builtin_amdgcn_sched_barrier(0);
      }
      __syncthreads();
    }
    float rs[4];
#pragma unroll
    for (int jj = 0; jj < 4; ++jj) {
      float ss = 0.f;
#pragma unroll
      for (int v8 = 0; v8 < 8; ++v8) ss += oacc[v8][jj] * oacc[v8][jj];
      ss += __shfl_xor(ss, 1); ss += __shfl_xor(ss, 2); ss += __shfl_xor(ss, 4); ss += __shfl_xor(ss, 8);
      rs[jj] = rsqrtf(ss * (1.0f / 128.0f) + NORM_EPS);
    }
    {
      bf16 zgr[8][4];
#pragma unroll
      for (int v8 = 0; v8 < 8; ++v8)
#pragma unroll
        for (int jj = 0; jj < 4; ++jj)
          zgr[v8][jj] = z[(size_t)(tok0 + 16 * w + 4 * g + jj) * 5120 + 4096 + hd * 128 + v8 * 16 + r16];
      __builtin_amdgcn_sched_barrier(0);
#pragma unroll
      for (int v8 = 0; v8 < 8; ++v8) {
        const int col = hd * 128 + v8 * 16 + r16;
        const float ng = normg[col];
#pragma unroll
        for (int jj = 0; jj < 4; ++jj) {
          const int t = tok0 + 16 * w + 4 * g + jj;
          const float zg = bf2f(zgr[v8][jj]);
          const float val = oacc[v8][jj] * rs[jj] * ng * (zg * sigmoidf_(zg));
          og[(size_t)t * 1024 + col] = f2bf(val);
        }
      }
    }
  }
}

__device__ __forceinline__ void topk128(const bf16* __restrict__ sp, float (&top)[16]) {
#pragma unroll
  for (int p = 0; p < 16; ++p) top[p] = -INFINITY;
#pragma unroll 1
  for (int c8 = 0; c8 < 2; ++c8) {
    uint4 vv[8];
#pragma unroll
    for (int c = 0; c < 8; ++c) vv[c] = *(const uint4*)(sp + (c8 * 8 + c) * 8);
    __builtin_amdgcn_sched_barrier(0);
#pragma unroll
    for (int c = 0; c < 8; ++c) {
      const unsigned wv[4] = {vv[c].x, vv[c].y, vv[c].z, vv[c].w};
#pragma unroll
      for (int e = 0; e < 8; ++e) {
        const unsigned hbits = (e & 1) ? (wv[e >> 1] & 0xffff0000u) : (wv[e >> 1] << 16);
        const float x = __uint_as_float(hbits | (unsigned)((c8 * 8 + c) * 8 + e));
#pragma unroll
        for (int p = 15; p >= 1; --p) top[p] = __builtin_amdgcn_fmed3f(top[p - 1], top[p], x);
        top[0] = fmaxf(top[0], x);
      }
    }
  }
}
__device__ void peer_topk_phase(const bf16* __restrict__ s  , int* __restrict__ eidx, float* __restrict__ gate) {
  for (int idx = opaque_bid() * 256 + opaque_tid(); idx < T_TOK * 8; idx += gridDim.x * 256) {
    float t0[16], t1[16];
    topk128(s + (size_t)idx * 256, t0);
    topk128(s + (size_t)idx * 256 + 128, t1);
    float bs[16]; int be[16];
#pragma unroll
    for (int p = 0; p < 16; ++p) { bs[p] = -INFINITY; be[p] = 0; }
#pragma unroll
    for (int i = 0; i < 16; ++i)
#pragma unroll
      for (int j = 0; j < 16; ++j) {
        if ((i + 1) * (j + 1) <= 16) {
          const unsigned u0 = __float_as_uint(t0[i]), u1 = __float_as_uint(t1[j]);
          float x = __uint_as_float(u0 & ~127u) + __uint_as_float(u1 & ~127u);
          int xe = (int)((u0 & 127u) * 128u + (u1 & 127u));
#pragma unroll
          for (int p = 0; p < 16; ++p) {
            const bool c = x > bs[p];
            const float tv = c ? bs[p] : x;
            const int te = c ? be[p] : xe;
            bs[p] = c ? x : bs[p];
            be[p] = c ? xe : be[p];
            x = tv; xe = te;
          }
        }
      }
    float wgt[16], sum = 0.f;
#pragma unroll
    for (int p = 0; p < 16; ++p) { wgt[p] = __expf(bs[p] - bs[0]); sum += wgt[p]; }
    const float inv = 1.0f / sum;
#pragma unroll
    for (int p4 = 0; p4 < 4; ++p4) {
      *(int4*)(eidx + (size_t)idx * 16 + p4 * 4) = make_int4(be[p4 * 4], be[p4 * 4 + 1], be[p4 * 4 + 2], be[p4 * 4 + 3]);
      *(float4*)(gate + (size_t)idx * 16 + p4 * 4) = make_float4(wgt[p4 * 4] * inv, wgt[p4 * 4 + 1] * inv, wgt[p4 * 4 + 2] * inv, wgt[p4 * 4 + 3] * inv);
    }
  }
}

typedef float float2v __attribute__((ext_vector_type(2)));
__device__ __forceinline__ float dot16_fp8(int4 r, const float* x) {
  const int wv[4] = {r.x, r.y, r.z, r.w};
  float2v acc = {0.f, 0.f};
#pragma unroll
  for (int i = 0; i < 4; ++i) {
    const float2v lo = __builtin_amdgcn_cvt_pk_f32_fp8(wv[i], false);
    const float2v hi = __builtin_amdgcn_cvt_pk_f32_fp8(wv[i], true);
    const float2v x0 = {x[4 * i], x[4 * i + 1]}, x1 = {x[4 * i + 2], x[4 * i + 3]};
    acc = __builtin_elementwise_fma(lo, x0, acc);
    acc = __builtin_elementwise_fma(hi, x1, acc);
  }
  return acc.x + acc.y;
}
__device__ __forceinline__ void axpy16_fp8(float c, int4 r, float* y) {
  const int wv[4] = {r.x, r.y, r.z, r.w};
#pragma unroll
  for (int i = 0; i < 4; ++i) {
    const float2v lo = __builtin_amdgcn_cvt_pk_f32_fp8(wv[i], false);
    const float2v hi = __builtin_amdgcn_cvt_pk_f32_fp8(wv[i], true);
    y[4 * i] += c * lo.x; y[4 * i + 1] += c * lo.y; y[4 * i + 2] += c * hi.x; y[4 * i + 3] += c * hi.y;
  }
}
__device__ __forceinline__ int4 ld_row16(const unsigned char* rowp, unsigned loff) {
  asm volatile("" : "+s"(rowp));
  typedef int v4i_t __attribute__((ext_vector_type(4)));
  typedef const v4i_t __attribute__((address_space(1))) * gp_t;
  const v4i_t v = *(gp_t)(rowp + loff);
  return make_int4(v.x, v.y, v.z, v.w);
}
__device__ void peer_gather_phase(const float* __restrict__ h1, const unsigned char* __restrict__ ub, const unsigned char* __restrict__ vb,
                                  const float* __restrict__ usc, const float* __restrict__ vsc,
                                  const int* __restrict__ eidx, const float* __restrict__ gate, const float* __restrict__ gam,
                                  const float* __restrict__ bet, float* __restrict__ hout, bf16* __restrict__ hbf, char* smem) {
  const int tid = opaque_tid();
  const int bid_ = opaque_bid();
  const int lane = tid & 63;
  const int gw = bid_ * 4 + (tid >> 6), nw = gridDim.x * 4;
  const unsigned loff = (unsigned)lane * 16u;
  const int esel = lane >> 3;
  int* se = (int*)(smem + (tid >> 6) * 2048);
  float* sg = (float*)(se + 128);
  float* sc = sg + 128;
  for (int t = gw; t < T_TOK; t += nw) {
    float x[16], y[16];
    {
      const float* xr = h1 + (size_t)t * 1024 + lane * 16;
      float4 a0 = *(const float4*)xr, a1 = *(const float4*)(xr + 4), a2 = *(const float4*)(xr + 8), a3 = *(const float4*)(xr + 12);
      x[0] = a0.x; x[1] = a0.y; x[2] = a0.z; x[3] = a0.w; x[4] = a1.x; x[5] = a1.y; x[6] = a1.z; x[7] = a1.w;
      x[8] = a2.x; x[9] = a2.y; x[10] = a2.z; x[11] = a2.w; x[12] = a3.x; x[13] = a3.y; x[14] = a3.z; x[15] = a3.w;
    }
    int ereg0, ereg1;
    float gv0, gv1, iu0, iu1;
    {
      const int e0 = eidx[(size_t)t * 128 + lane], e1 = eidx[(size_t)t * 128 + 64 + lane];
      const float g0 = gate[(size_t)t * 128 + lane], g1 = gate[(size_t)t * 128 + 64 + lane];
      const int b0 = e0 >> 11, b1 = e1 >> 11;
      int rk0 = 0, rk1 = 0, base = 0;
#pragma unroll
      for (int bk = 0; bk < 8; ++bk) {
        const unsigned long long m0 = __ballot(b0 == bk), m1 = __ballot(b1 == bk);
        const int c0 = __popcll(m0), c1 = __popcll(m1);
        const int p0 = __builtin_amdgcn_mbcnt_hi((unsigned)(m0 >> 32), __builtin_amdgcn_mbcnt_lo((unsigned)m0, 0u));
        const int p1 = __builtin_amdgcn_mbcnt_hi((unsigned)(m1 >> 32), __builtin_amdgcn_mbcnt_lo((unsigned)m1, 0u));
        rk0 = (b0 == bk) ? (base + p0) : rk0;
        rk1 = (b1 == bk) ? (base + c0 + p1) : rk1;
        base += c0 + c1;
      }
      se[rk0] = e0; se[rk1] = e1; sg[rk0] = g0; sg[rk1] = g1;
      __builtin_amdgcn_fence(__ATOMIC_RELEASE, "wavefront");
      __builtin_amdgcn_wave_barrier();
      __builtin_amdgcn_fence(__ATOMIC_ACQUIRE, "wavefront");
      ereg0 = se[lane]; ereg1 = se[64 + lane];
      gv0 = sg[lane] * vsc[ereg0]; gv1 = sg[64 + lane] * vsc[ereg1];
      iu0 = usc[ereg0]; iu1 = usc[ereg1];
      __builtin_amdgcn_wave_barrier();
    }
#define G_LDROWS(DST, TBL, BT) do { const int es_ = ((BT) < 8) ? ereg0 : ereg1; const int eb_ = ((BT) & 7) * 8; \
      _Pragma("unroll") for (int k = 0; k < 8; ++k) { const int id_ = __builtin_amdgcn_readlane(es_, eb_ + k); DST[k] = ld_row16(TBL + (size_t)id_ * 1024, loff); } } while (0)
#define G_PASS1(SRC, BT) do { const int eb_ = ((BT) & 7) * 8; \
      float d_[8]; \
      _Pragma("unroll") for (int k = 0; k < 8; ++k) d_[k] = dot16_fp8(SRC[k], x); \
      float q4_[4], q2_[2], q1_; \
      _Pragma("unroll") for (int k = 0; k < 4; ++k) { \
        const auto r_ = __builtin_amdgcn_permlane32_swap(__float_as_uint(d_[k]), __float_as_uint(d_[k + 4]), false, false); \
        q4_[k] = __uint_as_float(r_[0]) + __uint_as_float(r_[1]); } \
      _Pragma("unroll") for (int k = 0; k < 2; ++k) { \
        const auto r_ = __builtin_amdgcn_permlane16_swap(__float_as_uint(q4_[k]), __float_as_uint(q4_[k + 2]), false, false); \
        q2_[k] = __uint_as_float(r_[0]) + __uint_as_float(r_[1]); } \
      { const bool hi_ = (lane & 8) != 0; const float keep_ = hi_ ? q2_[1] : q2_[0]; const float send_ = hi_ ? q2_[0] : q2_[1]; \
        q1_ = keep_ + __int_as_float(__builtin_amdgcn_update_dpp(0, __float_as_int(send_), 0x128, 0xF, 0xF, true)); } \
      q1_ += __int_as_float(__builtin_amdgcn_update_dpp(0, __float_as_int(q1_), 0xB1, 0xF, 0xF, true)); \
      q1_ += __int_as_float(__builtin_amdgcn_update_dpp(0, __float_as_int(q1_), 0x4E, 0xF, 0xF, true)); \
      q1_ += __int_as_float(__builtin_amdgcn_update_dpp(0, __float_as_int(q1_), 0x141, 0xF, 0xF, true)); \
      ddacc = ((((BT) & 7) == (lane & 7))) ? q1_ : ddacc; } while (0)
#define G_FINISH_HALF(HALF) do { const int slot_ = 8 * (lane & 7) + (lane >> 3); \
      const float dd_ = ddacc * __shfl((HALF) ? iu1 : iu0, slot_); \
      const float hid_ = 0.5f * dd_ * (1.0f + erff(dd_ * 0.7071067811865476f)); \
      sc[(HALF) * 64 + slot_] = hid_ * __shfl((HALF) ? gv1 : gv0, slot_); } while (0)
    float ddacc = 0.f;
    {
      int4 rA[8], rB[8];
      G_LDROWS(rA, ub, 0);
      __builtin_amdgcn_sched_barrier(0);
#pragma unroll 1
      for (int bt = 0; bt < 16; bt += 2) {
        G_LDROWS(rB, ub, bt + 1);
        __builtin_amdgcn_sched_barrier(0);
        G_PASS1(rA, bt);
        __builtin_amdgcn_sched_barrier(0);
        if (bt + 2 < 16) G_LDROWS(rA, ub, bt + 2);
        __builtin_amdgcn_sched_barrier(0);
        G_PASS1(rB, bt + 1);
        if (((bt + 1) & 7) == 7) G_FINISH_HALF(bt >> 3);
        __builtin_amdgcn_sched_barrier(0);
      }
    }
    __builtin_amdgcn_fence(__ATOMIC_RELEASE, "wavefront");
    __builtin_amdgcn_wave_barrier();
    __builtin_amdgcn_fence(__ATOMIC_ACQUIRE, "wavefront");
    const float cf0 = sc[lane], cf1 = sc[64 + lane];
    __builtin_amdgcn_wave_barrier();
#pragma unroll
    for (int i = 0; i < 16; ++i) y[i] = 0.f;
#define G_PASS2(SRC, BT) do { const int eb_ = ((BT) & 7) * 8; const int cs_ = __float_as_int(((BT) < 8) ? cf0 : cf1); \
      _Pragma("unroll") for (int k = 0; k < 8; ++k) { const float c_ = __int_as_float(__builtin_amdgcn_readlane(cs_, eb_ + k)); axpy16_fp8(c_, SRC[k], y); } } while (0)
    {
      int4 rA[8];
#pragma unroll 1
      for (int bt = 0; bt < 16; ++bt) {
        G_LDROWS(rA, vb, bt);
        __builtin_amdgcn_sched_barrier(0);
        G_PASS2(rA, bt);
        __builtin_amdgcn_sched_barrier(0);
      }
    }
    {
      const float* xr = h1 + (size_t)t * 1024 + lane * 16;
      float4 a0 = *(const float4*)xr, a1 = *(const float4*)(xr + 4), a2 = *(const float4*)(xr + 8), a3 = *(const float4*)(xr + 12);
      asm volatile("" : "+v"(a0.x), "+v"(a1.x), "+v"(a2.x), "+v"(a3.x));
      x[0] = a0.x; x[1] = a0.y; x[2] = a0.z; x[3] = a0.w; x[4] = a1.x; x[5] = a1.y; x[6] = a1.z; x[7] = a1.w;
      x[8] = a2.x; x[9] = a2.y; x[10] = a2.z; x[11] = a2.w; x[12] = a3.x; x[13] = a3.y; x[14] = a3.z; x[15] = a3.w;
    }
    float sm = 0.f;
#pragma unroll
    for (int i = 0; i < 16; ++i) { y[i] = DN_ALPHA * x[i] + y[i]; sm += y[i]; }
    const float mu = wave_sum(sm) * (1.0f / 1024.0f);
    float qq = 0.f;
#pragma unroll
    for (int i = 0; i < 16; ++i) { const float dd = y[i] - mu; qq += dd * dd; }
    const float rstd = rsqrtf(wave_sum(qq) * (1.0f / 1024.0f) + NORM_EPS);
    const int col = lane * 16;
    float o[16];
#pragma unroll
    for (int c4 = 0; c4 < 4; ++c4) {
      const float4 g0 = *(const float4*)(gam + col + c4 * 4), b0 = *(const float4*)(bet + col + c4 * 4);
      o[c4 * 4 + 0] = (y[c4 * 4 + 0] - mu) * rstd * g0.x + b0.x; o[c4 * 4 + 1] = (y[c4 * 4 + 1] - mu) * rstd * g0.y + b0.y;
      o[c4 * 4 + 2] = (y[c4 * 4 + 2] - mu) * rstd * g0.z + b0.z; o[c4 * 4 + 3] = (y[c4 * 4 + 3] - mu) * rstd * g0.w + b0.w;
      *(float4*)(hout + (size_t)t * 1024 + col + c4 * 4) = make_float4(o[c4 * 4], o[c4 * 4 + 1], o[c4 * 4 + 2], o[c4 * 4 + 3]);
    }
    *(uint4*)(hbf + (size_t)t * 1024 + col) = make_uint4(pack2(o[0], o[1]), pack2(o[2], o[3]), pack2(o[4], o[5]), pack2(o[6], o[7]));
    *(uint4*)(hbf + (size_t)t * 1024 + col + 8) = make_uint4(pack2(o[8], o[9]), pack2(o[10], o[11]), pack2(o[12], o[13]), pack2(o[14], o[15]));
  }
}

#define XB_TMO      128
#define XB_XCNT(j)  (256  + 64 * (j))
#define XB_XSUB(j)  (1280 + 64 * (j))
#define XB_XGEN(j)  (2304 + 64 * (j))
#define XB_TOP      3328
#define XB_TOPGEN   3392
#define XCD_BAR_WORDS 3456
#define XB_SPIN_CAP (1u << 22)
#define LAS __attribute__((address_space(3)))
__device__ __forceinline__ unsigned xb_ld(unsigned* p) { return __hip_atomic_load(p, __ATOMIC_RELAXED, __HIP_MEMORY_SCOPE_AGENT); }
__device__ __forceinline__ unsigned xb_add(unsigned* p, unsigned v) { return __hip_atomic_fetch_add(p, v, __ATOMIC_RELAXED, __HIP_MEMORY_SCOPE_AGENT); }
__device__ __forceinline__ unsigned xb_xcc_id() { return (unsigned)__builtin_amdgcn_s_getreg((3 << 11) | 20) & 0xFu; }
#define XB_SPIN(cond, bar) do { unsigned _sp = 0; while (cond) { __builtin_amdgcn_s_sleep(1); \
    if ((++_sp & 255u) == 0u) { if (xb_ld(&(bar)[XB_TMO])) break; if (_sp > XB_SPIN_CAP) { atomicAdd(&(bar)[XB_TMO], 1u); break; } } } } while (0)
struct XcdBarrier { unsigned* bar; unsigned x; volatile LAS unsigned* st; };
__device__ __forceinline__ XcdBarrier xcd_barrier_post(unsigned* bar, volatile LAS unsigned* st) {
  XcdBarrier b; b.bar = bar; b.x = xb_xcc_id(); b.st = st;
  if (threadIdx.x == 0) (void)xb_add(&bar[XB_XCNT(b.x)], 1u);
  return b;
}
__device__ __forceinline__ void xcd_barrier_complete(unsigned* bar, unsigned x, unsigned& nloc, unsigned& nx) {
  const unsigned G = gridDim.x * gridDim.y * gridDim.z;
  unsigned sum, cnt, mine, sp = 0u;
  for (;;) {
    sum = 0u; cnt = 0u; mine = 0u;
#pragma unroll
    for (unsigned j = 0; j < 16; ++j) { const unsigned c = xb_ld(&bar[XB_XCNT(j)]); sum += c; cnt += (c > 0u) ? 1u : 0u; mine = (j == x) ? c : mine; }
    if (sum == G) break;
    __builtin_amdgcn_s_sleep(1);
    if ((++sp & 255u) == 0u) { if (xb_ld(&bar[XB_TMO])) break; if (sp > XB_SPIN_CAP) { atomicAdd(&bar[XB_TMO], 1u); break; } }
  }
  nloc = mine > 0u ? mine : 1u; nx = cnt > 0u ? cnt : 1u;
}
__device__ __forceinline__ void xcd_barrier(const XcdBarrier& b) {
  asm volatile("s_waitcnt vmcnt(0)" ::: "memory");
  __syncthreads();
  if (threadIdx.x == 0) {
    unsigned* bar = b.bar;
    asm volatile("" : "+s"(bar));
    __builtin_amdgcn_s_waitcnt(0);
    unsigned nloc = b.st[0], nx = b.st[1];
    if (nloc == 0u) { xcd_barrier_complete(bar, b.x, nloc, nx); b.st[0] = nloc; b.st[1] = nx; }
    const unsigned old = xb_add(&bar[XB_XSUB(b.x)], 1u);
    const unsigned gen = old / nloc;
    if (old + 1u == (gen + 1u) * nloc) {
      __builtin_amdgcn_fence(__ATOMIC_RELEASE, "agent");
      asm volatile("s_waitcnt vmcnt(0)" ::: "memory");
      const unsigned og = xb_add(&bar[XB_TOP], 1u);
      const unsigned tg = og / nx;
      if (og + 1u == (tg + 1u) * nx) xb_add(&bar[XB_TOPGEN], 1u);
      else XB_SPIN(xb_ld(&bar[XB_TOPGEN]) == tg, bar);
      __builtin_amdgcn_fence(__ATOMIC_ACQUIRE, "agent");
      xb_add(&bar[XB_XGEN(b.x)], 1u);
      asm volatile("s_waitcnt vmcnt(0)" ::: "memory");
    } else {
      XB_SPIN(xb_ld(&bar[XB_XGEN(b.x)]) == gen, bar);
      __builtin_amdgcn_fence(__ATOMIC_ACQUIRE, "agent");
      asm volatile("s_waitcnt vmcnt(0)" ::: "memory");
    }
  }
  __syncthreads();
}

#define SMEM_BYTES 61440
__global__ void __launch_bounds__(256, 2) mega_kernel(Params p) {
  __shared__ __attribute__((aligned(16))) char smem[SMEM_BYTES + 16];
  cg::grid_group grid = cg::this_grid();
  char* ws = p.ws;
  bf16* na_in_t = (bf16*)(ws + OFF_NA_IN_T);
  bf16* na_out_t = (bf16*)(ws + OFF_NA_OUT_T);
  bf16* mla_in_t = (bf16*)(ws + OFF_MLA_IN_T);
  bf16* mla_qup_t = (bf16*)(ws + OFF_MLA_QUP_T);
  bf16* mla_kvup_t = (bf16*)(ws + OFF_MLA_KVUP_T);
  bf16* mla_out_t = (bf16*)(ws + OFF_MLA_OUT_T);
  bf16* hg_in_t = (bf16*)(ws + OFF_HG_IN_T);
  bf16* hg_out_t = (bf16*)(ws + OFF_HG_OUT_T);
  bf16* peer_wq_t = (bf16*)(ws + OFF_PEER_WQ_T);
  bf16* peer_keys = (bf16*)(ws + OFF_PEER_KEYS);
  unsigned char* ub = (unsigned char*)(ws + OFF_UB);
  unsigned char* vb = (unsigned char*)(ws + OFF_VB);
  float* usc = (float*)(ws + OFF_USC);
  float* vsc = (float*)(ws + OFF_VSC);
  float* hA = (float*)(ws + OFF_HA);
  float* hB = (float*)(ws + OFF_HB);
  bf16* hbf = (bf16*)(ws + OFF_HBF);
  float* mix = (float*)(ws + OFF_MIX);
  char* R1 = ws + OFF_R1;
  char* R2 = ws + OFF_R2;
  bf16* obf = (bf16*)(ws + OFF_OBF);
  int* eidx = (int*)(ws + OFF_EIDX);
  float* gate = (float*)(ws + OFF_GATE);
  bf16* vtb = (bf16*)(ws + OFF_VT);
  float* dec = (float*)(ws + OFF_DEC);
  float* lbv = (float*)(ws + OFF_LB);
  float* ropet = (float*)(ws + OFF_ROPE);
  unsigned* bar = (unsigned*)(ws + OFF_BAR);
  if (threadIdx.x == 0) *(uint4*)(smem + SMEM_BYTES) = make_uint4(0u, 0u, 0u, 0u);
  __syncthreads();
  XcdBarrier xb = xcd_barrier_post(bar, (volatile LAS unsigned*)(smem + SMEM_BYTES));

  if (gridDim.x == 0x7fffffffu) grid.sync();

#pragma unroll 1
  for (int layer = 0; layer < 4; ++layer) {
    const int kind = layer % 3;
    const int j = layer / 3;
    const float* hin = (layer == 0) ? p.in[0] : hB;
    bf16* qk = (bf16*)R1;
    float* hmla = (float*)R1;
    bf16* qb = (bf16*)(R1 + (size_t)T_TOK * 640 * 4);
    bf16* knb = qb + (size_t)T_TOK * 1536;
    bf16* cqn = (bf16*)R2;
    bf16* ckvn = cqn + (size_t)T_TOK * 256;
    bf16* kpe = ckvn + (size_t)T_TOK * 256;
    bf16* z = (bf16*)R1;
    bf16* local = (bf16*)R2;
    bf16* pq = (bf16*)R1;
    bf16* psb = (bf16*)R2;
#pragma unroll 1
    for (int sub = (layer == 0) ? -1 : 0; sub < 10; ++sub) {
      bool did = true;
      switch (sub) {
        case -1: {
      #pragma unroll 1
        for (int job = 0; job < 14; ++job) {
          const float* src; bf16* dst; int K = 1024, N = 1024, Np = 1024;
          switch (job) {
            case 0: case 1: src = p.in[1] + (size_t)job * 1024 * 3072; dst = na_in_t + (size_t)job * 3072 * 1024; N = 3072; Np = 3072; break;
            case 2: case 3: src = p.in[3] + (size_t)(job - 2) * 1024 * 1024; dst = na_out_t + (size_t)(job - 2) * 1024 * 1024; break;
            case 4: src = p.in[4]; dst = mla_in_t; N = 544; Np = 640; break;
            case 5: src = p.in[7]; dst = mla_qup_t; K = 256; N = 1536; Np = 1536; break;
            case 6: src = p.in[8]; dst = mla_kvup_t; K = 256; N = 2048; Np = 2048; break;
            case 7: src = p.in[9]; dst = mla_out_t; break;
            case 8: src = p.in[10]; dst = hg_in_t; N = 5120; Np = 5120; break;
            case 9: src = p.in[13]; dst = hg_out_t; break;
            default: src = p.in[14] + (size_t)(job - 10) * 1024 * 2048; dst = peer_wq_t + (size_t)(job - 10) * 2048 * 1024; N = 2048; Np = 2048; break;
          }
          transpose_cvt(src, dst, K, N, Np, smem);
        }
        cvt_bf16(p.in[15], peer_keys, (size_t)4 * 2 * 128 * 128);
        cvt_fp8_rows(p.in[16], ub, usc, 4 * 16384);
        cvt_fp8_rows(p.in[17], vb, vsc, 4 * 16384);
        cvt_bf16(p.in[0], hbf, (size_t)T_TOK * 1024);
        for (int i = opaque_bid() * 256 + opaque_tid(); i < 4096 * 16; i += gridDim.x * 256) {
          const float invf = powf(10000.0f, -(float)(i & 15) * (1.0f / 16.0f));
          const float ang = (float)(i >> 4) * invf;
          ropet[i] = cosf(ang);
          ropet[4096 * 16 + i] = sinf(ang);
        }
        {
          const float* lbp = p.in[11];
          for (int i = opaque_bid() * 256 + opaque_tid(); i < 2048; i += gridDim.x * 256) {
            float a0 = lbp[i], a1 = lbp[2048 + i], a2 = lbp[4096 + i], a3 = lbp[6144 + i];
            float mx = fmaxf(fmaxf(a0, a1), fmaxf(a2, a3));
            float e0 = expf(a0 - mx), e1 = expf(a1 - mx), e2 = expf(a2 - mx), e3 = expf(a3 - mx);
            lbv[i] = (e1 + e2) / (e0 + e1 + e2 + e3);
          }
        }
        } break;
        case 0:
          if (kind == 0) gemm_bt<8>(hbf, 1024, na_in_t + (size_t)j * 3072 * 1024, 1024, T_TOK, 3072, 1024, EpiNAqkv{qk, vtb}, smem);
          else if (kind == 1) gemm_bt<4>(hbf, 1024, mla_in_t, 1024, T_TOK, 640, 1024, EpiF32{hmla, 640}, smem);
          else gemm_bt<8>(hbf, 1024, hg_in_t, 1024, T_TOK, 5120, 1024, EpiHGin{z, vtb}, smem);
          break;
        case 1:
          if (kind == 0) na_attn_phase(qk, vtb, p.in[2] + (size_t)j * 16 * 15 * 31, obf, smem);
          else if (kind == 1) mla_prep_phase(hmla, ropet, p.in[5], p.in[6], cqn, ckvn, kpe);
          else hg_local_phase(z, vtb, lbv, local, dec, smem);
          break;
        case 2:
          if (kind == 1) {
            gemm_bt<8>(cqn, 256, mla_qup_t, 256, T_TOK, 1536, 256, EpiBF16{qb, 1536}, smem);
            gemm_bt<8>(ckvn, 256, mla_kvup_t, 256, T_TOK, 2048, 256, EpiMLAkv{knb, vtb}, smem);
          } else if (kind == 2) hg_prefix_phase(local, dec);
          else did = false;
          break;
        case 3:
          if (kind == 1) mla_attn_phase(qb, knb, kpe, vtb, obf, ropet, smem);
          else if (kind == 2) hg_out_phase(z, vtb, lbv, local, p.in[12], obf, smem);
          else did = false;
          break;
        case 4: {
          const bf16* wo = (kind == 0) ? (na_out_t + (size_t)j * 1024 * 1024) : (kind == 1) ? mla_out_t : hg_out_t;
          gemm_bt<8>(obf, 1024, wo, 1024, T_TOK, 1024, 1024, EpiF32{mix, 1024}, smem);
        } break;
        case 5:
          ln_phase(hin, mix, p.in[18] + layer * 1024, p.in[19] + layer * 1024, hA, hbf);
          break;
        case 6:
          gemm_bt<8>(hbf, 1024, peer_wq_t + (size_t)layer * 2048 * 1024, 1024, T_TOK, 2048, 1024, EpiBF16{pq, 2048}, smem);
          break;
        case 7:
#pragma unroll 1
          for (int c = 0; c < 2; ++c)
            gemm_bt<4>(pq + c * 128, 256, peer_keys + (size_t)(layer * 2 + c) * 128 * 128, 128, T_TOK * 8, 128, 128, EpiBF16{psb + c * 128, 256}, smem);
          break;
        case 8:
          peer_topk_phase(psb, eidx, gate);
          break;
        default: {
          float* hout = (layer == 3) ? p.out : hB;
          peer_gather_phase(hA, ub + (size_t)layer * 16384 * 1024, vb + (size_t)layer * 16384 * 1024, usc + layer * 16384, vsc + layer * 16384,
                            eidx, gate, p.in[20] + layer * 1024, p.in[21] + layer * 1024, hout, hbf, smem);
        } break;
      }
      if (did && !(layer == 3 && sub == 9)) xcd_barrier(xb);
    }
  }
}

extern "C" void kernel_launch(void* const* d_in, const int* in_sizes, int n_in, void* d_out, int out_size, void* d_ws,
                              size_t ws_size, hipStream_t stream) {
  static int grid_blocks = 0;
  if (!grid_blocks) {
    int dev = 0, cus = 0, per_cu = 0;
    hipGetDevice(&dev);
    hipDeviceGetAttribute(&cus, hipDeviceAttributeMultiprocessorCount, dev);
    hipOccupancyMaxActiveBlocksPerMultiprocessor(&per_cu, mega_kernel, 256, 0);
    if (per_cu < 1) per_cu = 1;
    if (per_cu > 2) per_cu = 2;
    grid_blocks = cus * per_cu;
  }
  Params p{};
  for (int i = 0; i < 22; ++i) p.in[i] = (const float*)d_in[i];
  p.out = (float*)d_out;
  p.ws = (char*)d_ws;
  hipMemsetAsync((char*)d_ws + OFF_BAR, 0, 16384, stream);
  void* args[] = {&p};
  hipError_t e = hipLaunchCooperativeKernel((void*)mega_kernel, dim3(grid_blocks), dim3(256), args, 0, stream);
  if (e != hipSuccess) fprintf(stderr, "cooperative launch failed: %s (grid %d)\n", hipGetErrorString(e), grid_blocks);
}
```
